# Optimizing an MI355X kernel written in HIP

```python
import math
import jax
import jax.numpy as jnp
from jax import lax
import numpy as np

D_MODEL = 1024
BATCH = 2
SEQ = 8192
DEPTH = 1

CHUNK = 64
EPS = 1e-6

A_HEADS = 8
A_DK = 128
A_DV = 128
A_QK = A_HEADS * A_DK
A_V = A_HEADS * A_DV
CONV_W = 4
CONV_CH = 2 * A_QK + A_V

B_HEADS = 8
B_DK = 128
B_DV = 128
B_K = B_HEADS * B_DK
B_V = B_HEADS * B_DV

IN_SPLITS = (A_QK, A_QK, A_V, A_HEADS, A_HEADS, A_V, B_K, B_V, B_K, B_V, D_MODEL, D_MODEL)
IN_WIDTH = 3 * A_QK + 2 * A_V + 2 * A_HEADS + 2 * B_K + 2 * B_V + 2 * D_MODEL

N_KEYS = 128
N_EXPERTS = N_KEYS * N_KEYS
P_HEADS = 8
P_DKEY = 256
P_DHALF = P_DKEY // 2
P_TOPK = 16
P_TOKEN_BLOCK = 128

kernel_name = 'hybrid_gdn_hgrn2_peer_block'


def _rmsnorm(x, g):
    xf = x.astype(jnp.float32)
    y = xf * lax.rsqrt(jnp.mean(xf * xf, axis=-1, keepdims=True) + EPS) * g.astype(jnp.float32)
    return y.astype(x.dtype)


def _l2norm(x):
    return x * lax.rsqrt(jnp.sum(x * x, axis=-1, keepdims=True) + EPS)


def _split_cols(p):
    outs = []
    off = 0
    for w in IN_SPLITS:
        outs.append(p[..., off:off + w])
        off += w
    return outs


def _causal_conv_silu(x, w):
    k_w = w.shape[0]
    t = x.shape[1]
    xp = jnp.pad(x, ((0, 0), (k_w - 1, 0), (0, 0)))
    y = sum(xp[:, j:j + t] * w[j] for j in range(k_w))
    return jax.nn.silu(y)


def _to_chunks(x):
    b, t, h, d = x.shape
    return x.reshape(b, t // CHUNK, CHUNK, h, d).transpose(1, 0, 3, 2, 4)


def _to_chunks_s(x):
    b, t, h = x.shape
    return x.reshape(b, t // CHUNK, CHUNK, h).transpose(1, 0, 3, 2)


def _from_chunks(o):
    n, b, h, c, d = o.shape
    return o.transpose(1, 0, 3, 2, 4).reshape(b, n * c, h, d)


def _gated_delta_rule(q, k, v, beta, g):
    dk = q.shape[-1]
    dv = v.shape[-1]
    q = _l2norm(q) * (dk ** -0.5)
    k = _l2norm(k)
    qc, kc, vc = _to_chunks(q), _to_chunks(k), _to_chunks(v)
    bc = _to_chunks_s(beta)
    G = jnp.cumsum(_to_chunks_s(g), axis=-1)
    causal = jnp.tril(jnp.ones((CHUNK, CHUNK), dtype=bool))
    diff = G[..., :, None] - G[..., None, :]
    decay = jnp.where(causal, jnp.exp(jnp.where(causal, diff, 0.0)), 0.0)
    kb = kc * bc[..., None]
    a_kk = jnp.einsum('nbhid,nbhjd->nbhij', kb, kc) * decay
    lhs = jnp.eye(CHUNK, dtype=jnp.float32) + jnp.tril(a_kk, -1)
    rhs = jnp.concatenate([vc * bc[..., None], kb * jnp.exp(G)[..., None]], axis=-1)
    sol = lax.linalg.triangular_solve(lhs, rhs, left_side=True, lower=True, unit_diagonal=True)
    u, w = sol[..., :dv], sol[..., dv:]
    a_qk = jnp.einsum('nbhid,nbhjd->nbhij', qc, kc) * decay
    q_dec = qc * jnp.exp(G)[..., None]
    k_dec = kc * jnp.exp(G[..., -1:] - G)[..., None]
    g_last = jnp.exp(G[..., -1])

    def step(S, inp):
        u_n, w_n, aqk_n, qd_n, kd_n, gl_n = inp
        v_new = u_n - jnp.einsum('bhcd,bhde->bhce', w_n, S)
        o = jnp.einsum('bhcd,bhde->bhce', qd_n, S) + jnp.einsum('bhij,bhje->bhie', aqk_n, v_new)
        S = S * gl_n[..., None, None] + jnp.einsum('bhcd,bhce->bhde', kd_n, v_new)
        return S, o

    s0 = jnp.zeros((q.shape[0], q.shape[2], dk, dv), jnp.float32)
    _, o = lax.scan(step, s0, (u, w, a_qk, q_dec, k_dec, g_last))
    return _from_chunks(o)


def _hgrn2_recurrence(q, k, v, log_f):
    dk = q.shape[-1]
    dv = v.shape[-1]
    qc, kc, vc = _to_chunks(q), _to_chunks(k), _to_chunks(v)
    bc = jnp.cumsum(_to_chunks(log_f), axis=-2)
    causal3 = jnp.tril(jnp.ones((CHUNK, CHUNK), dtype=bool))[:, :, None]

    def step(S, inp):
        q_n, k_n, v_n, b_n = inp
        diff = b_n[..., :, None, :] - b_n[..., None, :, :]
        dec = jnp.where(causal3, jnp.exp(jnp.where(causal3, diff, 0.0)), 0.0)
        a = jnp.einsum('bhid,bhjd,bhijd->bhij', q_n, k_n, dec)
        o = jnp.einsum('bhid,bhde->bhie', q_n * jnp.exp(b_n), S) + jnp.einsum('bhij,bhje->bhie', a, v_n)
        b_last = b_n[..., -1:, :]
        S = S * jnp.exp(b_last)[..., 0, :, None] + jnp.einsum('bhjd,bhje->bhde', k_n * jnp.exp(b_last - b_n), v_n)
        return S, o

    s0 = jnp.zeros((q.shape[0], q.shape[2], dk, dv), jnp.float32)
    _, o = lax.scan(step, s0, (qc, kc, vc, bc))
    return _from_chunks(o)


def _peer(x, w_pq, sub_keys, expert_u, expert_v):
    b, t, d = x.shape
    n_tok = b * t
    xf = x.reshape(n_tok, d)
    q = (xf @ w_pq).reshape(n_tok, P_HEADS, 2, P_DHALF)
    s = jnp.einsum('thpd,phkd->thpk', q, sub_keys)
    top_s, top_i = lax.top_k(s, P_TOPK)
    cand_s = (top_s[:, :, 0, :, None] + top_s[:, :, 1, None, :]).reshape(n_tok, P_HEADS, P_TOPK * P_TOPK)
    cand_i = (top_i[:, :, 0, :, None] * N_KEYS + top_i[:, :, 1, None, :]).reshape(n_tok, P_HEADS, P_TOPK * P_TOPK)
    best_s, pos = lax.top_k(cand_s, P_TOPK)
    idx = jnp.take_along_axis(cand_i, pos, axis=-1)
    gate = jax.nn.softmax(best_s.astype(jnp.float32), axis=-1).astype(x.dtype)
    n_blk = n_tok // P_TOKEN_BLOCK
    xb = xf.reshape(n_blk, P_TOKEN_BLOCK, d)
    ib = idx.reshape(n_blk, P_TOKEN_BLOCK, P_HEADS * P_TOPK)
    gb = gate.reshape(n_blk, P_TOKEN_BLOCK, P_HEADS * P_TOPK)

    def block(args):
        xt, it, gt = args
        u = expert_u[it]
        h = jax.nn.gelu(jnp.einsum('td,tkd->tk', xt, u), approximate=False)
        v = expert_v[it]
        return jnp.einsum('tk,tkd->td', gt * h, v)

    y = lax.map(block, (xb, ib, gb))
    return y.reshape(b, t, d)


def setup_inputs(seed: int = 0) -> dict:
    key = jax.random.key(seed)
    ks = jax.random.split(key, 20)

    def nrm(k, shape, scale):
        return jax.random.normal(k, shape, jnp.float32) * scale

    x = nrm(ks[0], (BATCH, SEQ, D_MODEL), 1.0)
    norm1 = 1.0 + nrm(ks[1], (DEPTH, D_MODEL), 0.02)
    w_in = nrm(ks[2], (DEPTH, D_MODEL, IN_WIDTH), D_MODEL ** -0.5)
    conv_a = nrm(ks[3], (DEPTH, CONV_W, CONV_CH), CONV_W ** -0.5)
    a_log = jnp.log(jax.random.uniform(ks[4], (DEPTH, A_HEADS), jnp.float32, 1.0, 16.0))
    dt = jnp.exp(jax.random.uniform(ks[5], (DEPTH, A_HEADS), jnp.float32, math.log(1e-3), math.log(1e-1)))
    dt_bias = dt + jnp.log(-jnp.expm1(-dt))
    a_onorm = 1.0 + nrm(ks[6], (DEPTH, A_DV), 0.02)
    b_lower_bound = 1.0 + nrm(ks[7], (DEPTH + 1, B_K), 0.1)
    b_onorm = 1.0 + nrm(ks[8], (DEPTH, B_DV), 0.02)
    w_branch_a = nrm(ks[9], (DEPTH, A_V, D_MODEL), A_V ** -0.5)
    w_branch_b = nrm(ks[10], (DEPTH, B_V, D_MODEL), B_V ** -0.5)
    w_out = nrm(ks[11], (DEPTH, D_MODEL, D_MODEL), D_MODEL ** -0.5)
    norm2 = 1.0 + nrm(ks[12], (DEPTH, D_MODEL), 0.02)
    w_pq = nrm(ks[13], (DEPTH, D_MODEL, P_HEADS * P_DKEY), D_MODEL ** -0.5)
    sub_keys = nrm(ks[14], (DEPTH, 2, P_HEADS, N_KEYS, P_DHALF), P_DHALF ** -0.5)
    expert_u = nrm(ks[15], (DEPTH, N_EXPERTS, D_MODEL), D_MODEL ** -0.5)
    expert_v = nrm(ks[16], (DEPTH, N_EXPERTS, D_MODEL), P_HEADS ** -0.5)
    final_norm = 1.0 + nrm(ks[17], (D_MODEL,), 0.02)
    return {'x': x, 'norm1': norm1, 'w_in': w_in, 'conv_a': conv_a, 'a_log': a_log,
            'dt_bias': dt_bias, 'a_onorm': a_onorm, 'b_lower_bound': b_lower_bound,
            'b_onorm': b_onorm, 'w_branch_a': w_branch_a, 'w_branch_b': w_branch_b,
            'w_out': w_out, 'norm2': norm2, 'w_pq': w_pq, 'sub_keys': sub_keys,
            'expert_u': expert_u, 'expert_v': expert_v, 'final_norm': final_norm}


def reference(x, norm1, w_in, conv_a, a_log, dt_bias, a_onorm, b_lower_bound, b_onorm,
              w_branch_a, w_branch_b, w_out, norm2, w_pq, sub_keys, expert_u, expert_v,
              final_norm):
    dt = x.dtype
    bsz, t, _ = x.shape
    f32 = jnp.float32
    lower_bounds = jnp.cumsum(jax.nn.softmax(b_lower_bound.astype(f32), axis=0), axis=0)
    for l in range(DEPTH):
        h = _rmsnorm(x, norm1[l])
        proj = h @ w_in[l]
        a_q, a_k, a_v, a_beta, a_alpha, a_gate, b_f, b_i, b_q, b_gate, g_a, g_b = _split_cols(proj)

        qkv = _causal_conv_silu(jnp.concatenate([a_q, a_k, a_v], axis=-1), conv_a[l]).astype(f32)
        qa = qkv[..., :A_QK].reshape(bsz, t, A_HEADS, A_DK)
        ka = qkv[..., A_QK:2 * A_QK].reshape(bsz, t, A_HEADS, A_DK)
        va = qkv[..., 2 * A_QK:].reshape(bsz, t, A_HEADS, A_DV)
        beta = jax.nn.sigmoid(a_beta.astype(f32))
        log_alpha = -jnp.exp(a_log[l].astype(f32)) * jax.nn.softplus(a_alpha.astype(f32) + dt_bias[l].astype(f32))
        o_a = _gated_delta_rule(qa, ka, va, beta, log_alpha)
        o_a = _rmsnorm(o_a, a_onorm[l]) * jax.nn.silu(a_gate.astype(f32)).reshape(bsz, t, A_HEADS, A_DV)
        y_a = o_a.reshape(bsz, t, A_V).astype(dt) @ w_branch_a[l]

        lb = lower_bounds[l].reshape(B_HEADS, B_DK)
        f_gate = lb + (1.0 - lb) * jax.nn.sigmoid(b_f.astype(f32).reshape(bsz, t, B_HEADS, B_DK))
        qb = jax.nn.silu(b_q.astype(f32)).reshape(bsz, t, B_HEADS, B_DK)
        ib = b_i.astype(f32).reshape(bsz, t, B_HEADS, B_DV)
        o_b = _hgrn2_recurrence(qb, 1.0 - f_gate, ib, jnp.log(f_gate))
        o_b = _rmsnorm(o_b, b_onorm[l]) * jax.nn.sigmoid(b_gate.astype(f32)).reshape(bsz, t, B_HEADS, B_DV)
        y_b = o_b.reshape(bsz, t, B_V).astype(dt) @ w_branch_b[l]

        mix = jax.nn.sigmoid(g_a) * y_a + jax.nn.sigmoid(g_b) * y_b
        x = x + mix @ w_out[l]

        h2 = _rmsnorm(x, norm2[l])
        x = x + _peer(h2, w_pq[l], sub_keys[l], expert_u[l], expert_v[l])
    return _rmsnorm(x, final_norm)
```

```cpp
#include <hip/hip_runtime.h>
#include <cstdio>
#include <cstdint>

#ifndef MK_ONE_LAUNCH
#define MK_ONE_LAUNCH 1
#endif

namespace pg8 {
#define PG8_LAS __attribute__((address_space(3)))
typedef unsigned short bf16_t;
typedef short bf16x8 __attribute__((ext_vector_type(8)));
typedef float f32x4 __attribute__((ext_vector_type(4)));
typedef unsigned u32x4 __attribute__((ext_vector_type(4)));
typedef unsigned u32x2 __attribute__((ext_vector_type(2)));
constexpr int BM = 256, BK = 64, HALF = 128, HTB = HALF * BK * 2, STAGE_BYTES = 8 * HTB, NXCD = 8, WGM = 8;

__host__ __device__ __forceinline__ int lds_byte(int r, int c) { const int st = (r >> 4) * 2 + (c >> 5), rr = r & 15, cc = c & 31, ob = rr * 64 + cc * 2; return st * 1024 + (ob ^ (((ob >> 9) & 1) << 5)); }
__host__ __device__ __forceinline__ void stage_rc(int b, int& R, int& C) { const int st = b / 1024, sb = b % 1024, swz = sb ^ (((sb >> 9) & 1) << 5); R = (st >> 1) * 16 + swz / 64; C = (st & 1) * 32 + (swz % 64) / 2; }
__host__ __device__ __forceinline__ int perm32(int rho) { const int n = rho >> 4, i = rho & 15; return 8 * (i >> 2) + 4 * n + (i & 3); }

struct Unit { int pm, pn; };
struct Gemm { const bf16_t* A; const bf16_t* Bt; int M, N, K; };

struct StaticOrder {
    int nM, nN, nwg, G, c;
    __host__ __device__ void init(int M, int N, int G_, int c_) { nM = M / BM; nN = N / BM; nwg = nM * nN; G = G_; c = c_; }
    __host__ __device__ bool next(int i, Unit& u) const {
        const long L = (long)i * G + c; if (L >= nwg) return false;
        int wgid = (int)L; { const int q = nwg / NXCD, r = nwg % NXCD, xcd = wgid % NXCD, off = wgid / NXCD; wgid = (xcd < r ? xcd * (q + 1) : r * (q + 1) + (xcd - r) * q) + off; }
        const int nig = WGM * nN, gid = wgid / nig, fm = gid * WGM, gsz = (nM - fm) < WGM ? (nM - fm) : WGM;
        u.pm = fm + ((wgid % nig) % gsz); u.pn = (wgid % nig) / gsz; return true;
    }
    __device__ __forceinline__ void a_ready(const Unit&) const {}
    __device__ __forceinline__ void done(const Unit&) const {}
};

__device__ __forceinline__ unsigned cvt_pk_bf16(float lo, float hi) { unsigned r; asm volatile("v_cvt_pk_bf16_f32 %0, %1, %2" : "=v"(r) : "v"(lo), "v"(hi)); return r; }
__device__ __forceinline__ float bflo(unsigned w) { return __uint_as_float(w << 16); }
__device__ __forceinline__ float bfhi(unsigned w) { return __uint_as_float(w & 0xffff0000u); }
__device__ __forceinline__ float sigm(float x) { return __builtin_amdgcn_rcpf(1.f + __builtin_amdgcn_exp2f(x * -1.4426950408889634f)); }

struct EpiBf16 {
    static constexpr bool PERM = true, AFTER_DRAIN = false;
    bf16_t* O; int ldc;
    __device__ __forceinline__ void operator()(const f32x4 (&acc)[2][2][4][2], const Unit& u, int wr, int wc, int fr, int fq) const {
        const int row0 = u.pm * BM + wr * 64 + fr, col0 = u.pn * BM + wc * 32 + 8 * fq;
#pragma unroll
        for (int ai = 0; ai < 2; ++ai)
#pragma unroll
            for (int m = 0; m < 4; ++m) { bf16_t* rowp = O + (size_t)(row0 + ai * HALF + m * 16) * ldc + col0;
#pragma unroll
                for (int bj = 0; bj < 2; ++bj) { const f32x4 v0 = acc[ai][bj][m][0], v1 = acc[ai][bj][m][1];
                    u32x4 w; w.x = cvt_pk_bf16(v0[0], v0[1]); w.y = cvt_pk_bf16(v0[2], v0[3]); w.z = cvt_pk_bf16(v1[0], v1[1]); w.w = cvt_pk_bf16(v1[2], v1[3]);
                    *(u32x4*)(rowp + bj * HALF) = w; } }
    }
};
struct EpiP1 {
    static constexpr bool PERM = true, AFTER_DRAIN = false;
    bf16_t* P; bf16_t* GAB; bf16_t* OA; bf16_t* OB; float* BA; int seg;
    __device__ __forceinline__ void operator()(const f32x4 (&acc)[2][2][4][2], const Unit& u, int wr, int wc, int fr, int fq) const {
        const int row0 = u.pm * BM + wr * 64 + fr; int colt = u.pn * BM;
        if (u.pn == 40) {
            if (wc == 0 && fq < 2) {
#pragma unroll
                for (int ai = 0; ai < 2; ++ai)
#pragma unroll
                    for (int m = 0; m < 4; ++m) { const int lr = row0 + ai * HALF + m * 16; const int gr = (lr >> 11) * 8192 + seg * 2048 + (lr & 2047);
                        *(f32x4*)(BA + (size_t)gr * 16 + 8 * fq) = acc[ai][0][m][0]; *(f32x4*)(BA + (size_t)gr * 16 + 8 * fq + 4) = acc[ai][0][m][1]; } }
            return; }
        const int act = (u.pn >= 12 && u.pn < 16) ? 1 : ((u.pn >= 28) ? 2 : 0);
        const bool glob = act != 0;
        bf16_t* base = P; int ldc = 8192;
        if (act == 1) { base = OA; ldc = 1024; colt -= 3072; } else if (u.pn >= 32) { base = GAB; ldc = 2048; colt -= 8192; } else if (act == 2) { base = OB; ldc = 1024; colt -= 7168; }
        const int col0 = colt + wc * 32 + 8 * fq;
#pragma unroll
        for (int ai = 0; ai < 2; ++ai)
#pragma unroll
            for (int m = 0; m < 4; ++m) { const int lr = row0 + ai * HALF + m * 16; const int gr = (lr >> 11) * 8192 + seg * 2048 + (lr & 2047);
                bf16_t* rowp = base + (size_t)(glob ? gr : lr) * ldc + col0;
#pragma unroll
                for (int bj = 0; bj < 2; ++bj) { f32x4 v0 = acc[ai][bj][m][0], v1 = acc[ai][bj][m][1];
                    if (act) {
#pragma unroll
                        for (int j = 0; j < 4; ++j) { const float s0 = sigm(v0[j]), s1 = sigm(v1[j]); v0[j] = act == 1 ? v0[j] * s0 : s0; v1[j] = act == 1 ? v1[j] * s1 : s1; } }
                    u32x4 w; w.x = cvt_pk_bf16(v0[0], v0[1]); w.y = cvt_pk_bf16(v0[2], v0[3]); w.z = cvt_pk_bf16(v1[0], v1[1]); w.w = cvt_pk_bf16(v1[2], v1[3]);
                    *(u32x4*)(rowp + bj * HALF) = w; } }
    }
};
template <int MODE> struct EpiGate {
    static constexpr bool PERM = true, AFTER_DRAIN = false;
    const bf16_t* gate; int gate_ld; const float* addin; float* outf; bf16_t* outb; int ldc;
    __device__ __forceinline__ void operator()(const f32x4 (&acc)[2][2][4][2], const Unit& u, int wr, int wc, int fr, int fq) const {
        const int row0 = u.pm * BM + wr * 64 + fr, col0 = u.pn * BM + wc * 32 + 8 * fq;
#pragma unroll
        for (int ai = 0; ai < 2; ++ai)
#pragma unroll
            for (int m = 0; m < 4; ++m) { const size_t r = (size_t)(row0 + ai * HALF + m * 16);
#pragma unroll
                for (int bj = 0; bj < 2; ++bj) { const int c = col0 + bj * HALF;
                    const u32x4 gw = *(const u32x4*)(gate + r * gate_ld + c);
                    f32x4 v0 = acc[ai][bj][m][0], v1 = acc[ai][bj][m][1];
                    v0[0] *= bflo(gw.x); v0[1] *= bfhi(gw.x); v0[2] *= bflo(gw.y); v0[3] *= bfhi(gw.y); v1[0] *= bflo(gw.z); v1[1] *= bfhi(gw.z); v1[2] *= bflo(gw.w); v1[3] *= bfhi(gw.w);
                    if (MODE == 1) { const u32x4 aw = *(const u32x4*)((const bf16_t*)addin + r * ldc + c);
                        v0[0] += bflo(aw.x); v0[1] += bfhi(aw.x); v0[2] += bflo(aw.y); v0[3] += bfhi(aw.y); v1[0] += bflo(aw.z); v1[1] += bfhi(aw.z); v1[2] += bflo(aw.w); v1[3] += bfhi(aw.w); }
                    u32x4 w; w.x = cvt_pk_bf16(v0[0], v0[1]); w.y = cvt_pk_bf16(v0[2], v0[3]); w.z = cvt_pk_bf16(v1[0], v1[1]); w.w = cvt_pk_bf16(v1[2], v1[3]);
                    *(u32x4*)((MODE == 0 ? (bf16_t*)outf : outb) + r * ldc + c) = w; } }
    }
};
struct EpiRes {
    static constexpr bool PERM = false, AFTER_DRAIN = false;
    const float* base; float* out; int ldc;
    __device__ __forceinline__ void operator()(const f32x4 (&acc)[2][2][4][2], const Unit& u, int wr, int wc, int fr, int fq) const {
        const int row0 = u.pm * BM + wr * 64 + fr, col0 = u.pn * BM + wc * 32 + 4 * fq;
#pragma unroll
        for (int ai = 0; ai < 2; ++ai)
#pragma unroll
            for (int m = 0; m < 4; ++m) { const size_t r = (size_t)(row0 + ai * HALF + m * 16);
#pragma unroll
                for (int bj = 0; bj < 2; ++bj)
#pragma unroll
                    for (int n = 0; n < 2; ++n) { const int c = col0 + bj * HALF + n * 16;
                        *(f32x4*)(out + r * ldc + c) = *(const f32x4*)(base + r * ldc + c) + acc[ai][bj][m][n]; } }
    }
};

struct F1Order {
    StaticOrder S;
    __device__ __forceinline__ bool next(int i, Unit& u) const { if (i > 1 || !S.next(0, u)) return false; if (i == 1) { u.pm += 64; u.pn += 4; } return true; }
    __device__ __forceinline__ void a_ready(const Unit&) const {}
    __device__ __forceinline__ void done(const Unit&) const {}
};
struct EpiF1 {
    static constexpr bool PERM = true, AFTER_DRAIN = false;
    EpiGate<0> e0; EpiGate<1> e1;
    __device__ __forceinline__ void operator()(const f32x4 (&acc)[2][2][4][2], const Unit& u, int wr, int wc, int fr, int fq) const {
        if (u.pm < 64) e0(acc, u, wr, wc, fr, fq); else { Unit v; v.pm = u.pm - 64; v.pn = u.pn - 4; e1(acc, v, wr, wc, fr, fq); }
    }
};
struct EpiResNorm {
    static constexpr bool PERM = true, AFTER_DRAIN = true;
    const float* base; float* out; bf16_t* xb; const float* g2; float* ssp; int ldc;
    __device__ __forceinline__ void fused(f32x4 (&acc)[2][2][4][2], const Unit& u, int wr, int wc, int fr, int fq, PG8_LAS unsigned char* lds, int wid, int lane) const {
        PG8_LAS float* part = (PG8_LAS float*)lds;
        const int row0 = u.pm * BM + wr * 64 + fr, col0 = u.pn * BM + wc * 32 + 8 * fq;
        f32x4 gv[2][2];
#pragma unroll
        for (int bj = 0; bj < 2; ++bj)
#pragma unroll
            for (int n = 0; n < 2; ++n) gv[bj][n] = *(const f32x4*)(g2 + col0 + bj * HALF + 4 * n);
#pragma unroll
        for (int ai = 0; ai < 2; ++ai)
#pragma unroll
            for (int m = 0; m < 4; ++m) { const size_t r = (size_t)(row0 + ai * HALF + m * 16); float ss = 0.f;
#pragma unroll
                for (int bj = 0; bj < 2; ++bj) { const int c = col0 + bj * HALF;
                    const f32x4 xa = *(const f32x4*)(base + r * ldc + c) + acc[ai][bj][m][0], xc = *(const f32x4*)(base + r * ldc + c + 4) + acc[ai][bj][m][1];
                    ss += (xa[0] * xa[0] + xa[1] * xa[1]) + (xa[2] * xa[2] + xa[3] * xa[3]) + (xc[0] * xc[0] + xc[1] * xc[1]) + (xc[2] * xc[2] + xc[3] * xc[3]);
                    u32x4 xw; xw.x = cvt_pk_bf16(xa[0], xa[1]); xw.y = cvt_pk_bf16(xa[2], xa[3]); xw.z = cvt_pk_bf16(xc[0], xc[1]); xw.w = cvt_pk_bf16(xc[2], xc[3]);
                    *(u32x4*)((bf16_t*)out + r * (2 * ldc) + ldc + c) = xw;
                    const f32x4 ha = xa * gv[bj][0], hc = xc * gv[bj][1];
                    u32x4 hw; hw.x = cvt_pk_bf16(ha[0], ha[1]); hw.y = cvt_pk_bf16(ha[2], ha[3]); hw.z = cvt_pk_bf16(hc[0], hc[1]); hw.w = cvt_pk_bf16(hc[2], hc[3]);
                    *(u32x4*)(xb + r * ldc + c) = hw; }
                ss += __shfl_xor(ss, 16); ss += __shfl_xor(ss, 32);
                if (fq == 0) part[wc * 256 + ai * HALF + wr * 64 + m * 16 + fr] = ss; }
        asm volatile("s_waitcnt lgkmcnt(0)" ::: "memory"); __builtin_amdgcn_s_barrier(); asm volatile("" ::: "memory");
        const int t = wid * 64 + lane;
        if (t < 256) ssp[(size_t)(u.pm * BM + t) * 4 + u.pn] = (part[t] + part[256 + t]) + (part[512 + t] + part[768 + t]);
    }
};
struct EpiBf16RowScale {
    static constexpr bool PERM = true, AFTER_DRAIN = false;
    bf16_t* O; int ldc; const float* ssp; float inv_n, eps;
    __device__ __forceinline__ void operator()(const f32x4 (&acc)[2][2][4][2], const Unit& u, int wr, int wc, int fr, int fq) const {
        const int row0 = u.pm * BM + wr * 64 + fr, col0 = u.pn * BM + wc * 32 + 8 * fq;
#pragma unroll
        for (int ai = 0; ai < 2; ++ai)
#pragma unroll
            for (int m = 0; m < 4; ++m) { const size_t r = (size_t)(row0 + ai * HALF + m * 16); const f32x4 sp = *(const f32x4*)(ssp + r * 4);
                const float rs = __builtin_amdgcn_rsqf(((sp[0] + sp[1]) + (sp[2] + sp[3])) * inv_n + eps);
                bf16_t* rowp = O + r * ldc + col0;
#pragma unroll
                for (int bj = 0; bj < 2; ++bj) { const f32x4 v0 = acc[ai][bj][m][0] * rs, v1 = acc[ai][bj][m][1] * rs;
                    u32x4 w; w.x = cvt_pk_bf16(v0[0], v0[1]); w.y = cvt_pk_bf16(v0[2], v0[3]); w.z = cvt_pk_bf16(v1[0], v1[1]); w.w = cvt_pk_bf16(v1[2], v1[3]);
                    *(u32x4*)(rowp + bj * HALF) = w; } }
    }
};

template <class Epi, class Sched, bool ALIGN_EPI = false, bool SP2 = false>
__device__ __forceinline__ void gemm_phase(PG8_LAS unsigned char* lds, const Gemm g, const Sched& S, const Epi& E) {
    const int tid = threadIdx.x, wid = __builtin_amdgcn_readfirstlane(tid >> 6), lane = tid & 63, wr = wid >> 2, wc = wid & 3, fr = lane & 15, fq = lane >> 4;
    const int K = g.K, nt = K / BK;
    unsigned voffA[2], voffB[2];
#pragma unroll
    for (int i = 0; i < 2; ++i) { int R, C; stage_rc(tid * 16 + i * 8192, R, C); const int Rb = Epi::PERM ? ((R & ~31) + perm32(R & 31)) : R;
        voffA[i] = (unsigned)(R * K + C) * 2u; voffB[i] = (unsigned)(Rb * K + C) * 2u; }
    const size_t kstep = (size_t)(BK * 2);
    const size_t hstep = (size_t)HALF * K * 2;
    const size_t tstep = 2 * hstep;
    const unsigned ldsw = (unsigned)wid * 1024u;
    const int aoff = lds_byte(wr * 64 + fr, fq * 8), boff = lds_byte(wc * 32 + fr, fq * 8);
#define PG8_SA(b, h) (((b) * 2 + (h)) * HTB)
#define PG8_SB(b, h) ((4 + (b) * 2 + (h)) * HTB)
#define PG8_STAGE(bufoff, gbase, voff) do { _Pragma("unroll") for (int _i = 0; _i < 2; ++_i) \
        __builtin_amdgcn_global_load_lds((const unsigned*)((const char*)(gbase) + (voff)[_i]), (PG8_LAS unsigned*)(lds + (bufoff) + ldsw + _i * 8192), 16, 0, 0); } while (0)
#define PG8_LDA(dst, b, h) do { _Pragma("unroll") for (int m = 0; m < 4; ++m) _Pragma("unroll") for (int k = 0; k < 2; ++k) dst[m][k] = *(const PG8_LAS bf16x8*)(lds + PG8_SA(b, h) + aoff + m * 2048 + k * 1024); } while (0)
#define PG8_LDB(dst, b, h) do { _Pragma("unroll") for (int n = 0; n < 2; ++n) _Pragma("unroll") for (int k = 0; k < 2; ++k) dst[n][k] = *(const PG8_LAS bf16x8*)(lds + PG8_SB(b, h) + boff + n * 2048 + k * 1024); } while (0)
#define PG8_MMA(ai, bj, At, Bt) do { __builtin_amdgcn_s_setprio(1); _Pragma("unroll") for (int m = 0; m < 4; ++m) _Pragma("unroll") for (int n = 0; n < 2; ++n) _Pragma("unroll") for (int k = 0; k < 2; ++k) \
        acc[ai][bj][m][n] = __builtin_amdgcn_mfma_f32_16x16x32_bf16(Bt[n][k], At[m][k], acc[ai][bj][m][n], 0, 0, 0); __builtin_amdgcn_s_setprio(0); } while (0)
#define PG8_WAIT_V(n) asm volatile("s_waitcnt vmcnt(" #n ")" ::: "memory")
#define PG8_WAIT_L(n) asm volatile("s_waitcnt lgkmcnt(" #n ")" ::: "memory")
#define PG8_BAR __builtin_amdgcn_s_barrier()
#define PG8_SCHED __builtin_amdgcn_sched_barrier(0)
    Unit cur, nxt; int ui = 0;
    if (!S.next(0, cur)) return;
    f32x4 acc[2][2][4][2];
#pragma unroll
    for (int a = 0; a < 2; ++a)
#pragma unroll
        for (int b = 0; b < 2; ++b)
#pragma unroll
            for (int m = 0; m < 4; ++m)
#pragma unroll
                for (int n = 0; n < 2; ++n) acc[a][b][m][n] = (f32x4){0.f, 0.f, 0.f, 0.f};
    bf16x8 At[4][2], B0[2][2], B1[2][2];
    const char* cA = (const char*)g.A + (size_t)cur.pm * tstep; const char* cB = (const char*)g.Bt + (size_t)cur.pn * tstep;
    S.a_ready(cur);
    if constexpr (SP2) {
        PG8_STAGE(PG8_SB(0, 0), cB, voffB); PG8_STAGE(PG8_SB(0, 1), cB + hstep, voffB); PG8_STAGE(PG8_SA(0, 0), cA, voffA); PG8_STAGE(PG8_SA(0, 1), cA + hstep, voffA);
        if (wr == 1) PG8_BAR;
        PG8_WAIT_V(2); PG8_BAR;
        PG8_STAGE(PG8_SB(1, 0), cB + kstep, voffB); PG8_STAGE(PG8_SA(1, 0), cA + kstep, voffA); PG8_STAGE(PG8_SB(1, 1), cB + hstep + kstep, voffB);
        PG8_WAIT_V(6); PG8_BAR;
    } else {
        PG8_STAGE(PG8_SB(0, 0), cB, voffB); PG8_STAGE(PG8_SA(0, 0), cA, voffA); PG8_STAGE(PG8_SB(0, 1), cB + hstep, voffB); PG8_STAGE(PG8_SA(0, 1), cA + hstep, voffA);
        if (wr == 1) PG8_BAR;
        PG8_WAIT_V(4); PG8_BAR;
        PG8_STAGE(PG8_SB(1, 0), cB + kstep, voffB); PG8_STAGE(PG8_SA(1, 0), cA + kstep, voffA); PG8_STAGE(PG8_SB(1, 1), cB + hstep + kstep, voffB);
        PG8_WAIT_V(6); PG8_BAR;
    }
    for (;;) {
        const bool has_next = S.next(ui + 1, nxt);
        const char* nA = has_next ? (const char*)g.A + (size_t)nxt.pm * tstep : cA; const char* nB = has_next ? (const char*)g.Bt + (size_t)nxt.pn * tstep : cB;
        for (int t = 0; t < nt; t += 2) {
            const bool last = (t == nt - 2);
            const char* a1 = cA + (size_t)(t + 1) * kstep;
            const char* a2 = last ? nA : cA + (size_t)(t + 2) * kstep; const char* b2 = last ? nB : cB + (size_t)(t + 2) * kstep;
            const char* a3 = a2 + kstep; const char* b3 = b2 + kstep;
            if (last && has_next) S.a_ready(nxt);
            if constexpr (SP2) {
            PG8_LDB(B0, 0, 0); PG8_LDB(B1, 0, 1); PG8_SCHED; PG8_LDA(At, 0, 0); PG8_STAGE(PG8_SA(1, 1), a1 + hstep, voffA);
            PG8_WAIT_V(8); PG8_WAIT_L(0); PG8_BAR; PG8_MMA(0, 0, At, B0); PG8_MMA(0, 1, At, B1); PG8_BAR; PG8_SCHED;
            PG8_LDA(At, 0, 1); PG8_STAGE(PG8_SB(0, 0), b2, voffB); PG8_STAGE(PG8_SB(0, 1), b2 + hstep, voffB); PG8_STAGE(PG8_SA(0, 0), a2, voffA);
            PG8_WAIT_V(8); PG8_WAIT_L(0); PG8_BAR; PG8_MMA(1, 0, At, B0); PG8_MMA(1, 1, At, B1); PG8_BAR; PG8_SCHED;
            PG8_LDB(B0, 1, 0); PG8_LDB(B1, 1, 1); PG8_SCHED; PG8_LDA(At, 1, 0); PG8_STAGE(PG8_SA(0, 1), a2 + hstep, voffA);
            PG8_WAIT_V(8); PG8_WAIT_L(0); PG8_BAR; PG8_MMA(0, 0, At, B0); PG8_MMA(0, 1, At, B1); PG8_BAR; PG8_SCHED;
            PG8_LDA(At, 1, 1); PG8_STAGE(PG8_SB(1, 0), b3, voffB); PG8_STAGE(PG8_SB(1, 1), b3 + hstep, voffB); PG8_STAGE(PG8_SA(1, 0), a3, voffA);
            PG8_WAIT_V(8); PG8_WAIT_L(0); PG8_BAR; PG8_MMA(1, 0, At, B0); PG8_MMA(1, 1, At, B1); PG8_BAR; PG8_SCHED;
            } else {
            PG8_LDB(B0, 0, 0); PG8_SCHED; PG8_LDA(At, 0, 0); PG8_STAGE(PG8_SA(1, 1), a1 + hstep, voffA);
            PG8_WAIT_L(8); PG8_BAR; PG8_WAIT_L(0); PG8_MMA(0, 0, At, B0); PG8_BAR; PG8_SCHED;
            PG8_LDB(B1, 0, 1); PG8_STAGE(PG8_SB(0, 0), b2, voffB);
            PG8_BAR; PG8_WAIT_L(0); PG8_MMA(0, 1, At, B1); PG8_BAR;
            PG8_LDA(At, 0, 1); PG8_STAGE(PG8_SA(0, 0), a2, voffA);
            PG8_BAR; PG8_WAIT_L(0); PG8_MMA(1, 0, At, B0); PG8_BAR; PG8_SCHED;
            PG8_STAGE(PG8_SB(0, 1), b2 + hstep, voffB);
            PG8_WAIT_V(6); PG8_BAR; PG8_MMA(1, 1, At, B1); PG8_BAR;
            PG8_LDB(B0, 1, 0); PG8_SCHED; PG8_LDA(At, 1, 0); PG8_STAGE(PG8_SA(0, 1), a2 + hstep, voffA);
            PG8_WAIT_L(8); PG8_BAR; PG8_WAIT_L(0); PG8_MMA(0, 0, At, B0); PG8_BAR; PG8_SCHED;
            PG8_LDB(B1, 1, 1); PG8_STAGE(PG8_SB(1, 0), b3, voffB);
            PG8_BAR; PG8_WAIT_L(0); PG8_MMA(0, 1, At, B1); PG8_BAR;
            PG8_LDA(At, 1, 1); PG8_STAGE(PG8_SA(1, 0), a3, voffA);
            PG8_BAR; PG8_WAIT_L(0); PG8_MMA(1, 0, At, B0); PG8_BAR; PG8_SCHED;
            PG8_STAGE(PG8_SB(1, 1), b3 + hstep, voffB);
            PG8_WAIT_V(6); PG8_BAR; PG8_MMA(1, 1, At, B1); PG8_BAR;
            }
        }
        if constexpr (ALIGN_EPI) { if (wr == 0) PG8_BAR; }
        if constexpr (!Epi::AFTER_DRAIN) { E(acc, cur, wr, wc, fr, fq); S.done(cur); }
        if (!has_next) break;
#pragma unroll
        for (int a = 0; a < 2; ++a)
#pragma unroll
            for (int b = 0; b < 2; ++b)
#pragma unroll
                for (int m = 0; m < 4; ++m)
#pragma unroll
                    for (int n = 0; n < 2; ++n) acc[a][b][m][n] = (f32x4){0.f, 0.f, 0.f, 0.f};
        cur = nxt; cA = nA; cB = nB; ++ui;
        if constexpr (ALIGN_EPI) { if (wr == 1) PG8_BAR; }
    }
    PG8_WAIT_V(0);
    if constexpr (!ALIGN_EPI) { if (wr == 0) PG8_BAR; }
    PG8_BAR;
    if constexpr (Epi::AFTER_DRAIN) { E.fused(acc, cur, wr, wc, fr, fq, lds, wid, lane); S.done(cur); }
#undef PG8_SA
#undef PG8_SB
#undef PG8_STAGE
#undef PG8_LDA
#undef PG8_LDB
#undef PG8_MMA
#undef PG8_WAIT_V
#undef PG8_WAIT_L
#undef PG8_BAR
#undef PG8_SCHED
}
}

constexpr int NWAVES = 8, NTHREADS = 512;
constexpr int BATCH = 2, T = 8192, D = 1024, M = BATCH * T;
constexpr int NSEG = 4, TSEG = T / NSEG, MSEG = BATCH * TSEG;
constexpr int IN_W = 11280, NPROJ = 10496;
constexpr int NH = 8, DH = 128;
constexpr int NEXP = 16384, PH = 8, PTOPK = 16, NKEYS = 128;
constexpr float EPS = 1e-6f;

constexpr size_t MiB = 1u << 20;
constexpr size_t WS_CTL = 0, CTL_ZERO_BYTES = 32 * 1024;
constexpr size_t WS_BA = 1 * MiB, WS_STATE = 2 * MiB, WS_HIST = 4 * MiB, WS_SK = 4 * MiB + 512 * 1024;
constexpr size_t WS_WA = 5 * MiB, WS_WB = 7 * MiB, WS_WO = 9 * MiB, WS_WPQ = 11 * MiB, WS_WIN = 15 * MiB + 512 * 1024;
constexpr size_t WS_XN = 36 * MiB, WS_P = 52 * MiB, WS_OA = 116 * MiB, WS_OB = 148 * MiB, WS_PREP = 180 * MiB;
constexpr size_t WS_YA = 180 * MiB, WS_MIX = 16 * MiB, WS_H2 = 180 * MiB, WS_Q2 = 116 * MiB, WS_IDX = 212 * MiB, WS_GATE = 220 * MiB;
constexpr size_t WS_EU = 52 * MiB, WS_EV = 68 * MiB;
constexpr size_t WS_SSP = 228 * MiB;
constexpr size_t WS_NEED = 244 * MiB;
constexpr int CW_BAR = 4096;

constexpr int LDS_BYTES = 163840;
constexpr int MISC_OFF = LDS_BYTES - 256;

#define GAS __attribute__((address_space(1)))
#define LAS __attribute__((address_space(3)))
typedef unsigned short bf16;
typedef unsigned v4u __attribute__((ext_vector_type(4)));
typedef unsigned v2u __attribute__((ext_vector_type(2)));
typedef float f32x4 __attribute__((ext_vector_type(4)));
typedef GAS unsigned gu32;
#define RLX_AGENT __ATOMIC_RELAXED, __HIP_MEMORY_SCOPE_AGENT
#define LDS_WAIT() asm volatile("s_waitcnt lgkmcnt(0)" ::: "memory")
#define VM_WAIT() asm volatile("s_waitcnt vmcnt(0)" ::: "memory")
__device__ __forceinline__ unsigned f2bf(float f) { unsigned u = __builtin_bit_cast(unsigned, f); return (u + 0x7fffu + ((u >> 16) & 1u)) >> 16; }
__device__ __forceinline__ unsigned pk2(float lo, float hi) { return f2bf(lo) | (f2bf(hi) << 16); }
__device__ __forceinline__ float bf2f(unsigned short b) { return __uint_as_float(((unsigned)b) << 16); }
__device__ __forceinline__ float blo(unsigned w) { return __uint_as_float(w << 16); }
__device__ __forceinline__ float bhi(unsigned w) { return __uint_as_float(w & 0xffff0000u); }
__device__ __forceinline__ float fexp(float x) { return __builtin_amdgcn_exp2f(x * 1.4426950408889634f); }
__device__ __forceinline__ float sigmoid_f(float x) { return __builtin_amdgcn_rcpf(1.f + fexp(-x)); }
__device__ __forceinline__ float silu_f(float x) { return x * __builtin_amdgcn_rcpf(1.f + fexp(-x)); }
__device__ __forceinline__ float softplus_f(float x) { return fmaxf(x, 0.f) + log1pf(__expf(-fabsf(x))); }
typedef __bf16 bf2_t __attribute__((ext_vector_type(2)));
__device__ __forceinline__ float dot2bf(unsigned a, unsigned b, float c) { return __builtin_amdgcn_fdot2_f32_bf16(__builtin_bit_cast(bf2_t, a), __builtin_bit_cast(bf2_t, b), c, false); }
__device__ __forceinline__ float wave_sum(float v) {
#pragma unroll
    for (int o = 1; o < 64; o <<= 1) v += __shfl_xor(v, o);
    return v;
}

#define XB_TMO      128
#define XB_XCNT(j)  (256  + 64 * (j))
#define XB_XSUB(j)  (1280 + 64 * (j))
#define XB_XGEN(j)  (2304 + 64 * (j))
#define XB_TOP      3328
#define XB_TOPGEN   3392
#define XCD_BAR_WORDS 3456
#define XB_SPIN_CAP (1u << 18)

__device__ __forceinline__ unsigned xb_ld(unsigned* p)              { return __hip_atomic_load(p, __ATOMIC_RELAXED, __HIP_MEMORY_SCOPE_AGENT); }
__device__ __forceinline__ unsigned xb_add(unsigned* p, unsigned v) { return __hip_atomic_fetch_add(p, v, __ATOMIC_RELAXED, __HIP_MEMORY_SCOPE_AGENT); }
__device__ __forceinline__ unsigned xb_xcc_id() { return (unsigned)__builtin_amdgcn_s_getreg((3 << 11) | 20) & 0xFu; }
#define XB_SPIN(cond, bar) do { unsigned _sp = 0; while (cond) { __builtin_amdgcn_s_sleep(1); \
    if ((++_sp & 255u) == 0u) { if (xb_ld(&(bar)[XB_TMO])) break; if (_sp > XB_SPIN_CAP) { atomicAdd(&(bar)[XB_TMO], 1u); break; } } } } while (0)

struct XcdBarrier {
    unsigned* bar; unsigned x;
    volatile LAS unsigned* st;
};

__device__ __forceinline__ XcdBarrier xcd_barrier_post(unsigned* bar, volatile LAS unsigned* st) {
    XcdBarrier b; b.bar = bar; b.x = xb_xcc_id(); b.st = st;
    if (threadIdx.x == 0) (void)xb_add(&bar[XB_XCNT(b.x)], 1u);
    return b;
}
__device__ __forceinline__ void xcd_barrier_complete(unsigned* bar, unsigned x, unsigned& nloc, unsigned& nx) {
    const unsigned G = gridDim.x * gridDim.y * gridDim.z;
    unsigned sum, cnt, mine, sp = 0u;
    for (;;) {
        sum = 0u; cnt = 0u; mine = 0u;
#pragma unroll
        for (unsigned j = 0; j < 16; ++j) { const unsigned c = xb_ld(&bar[XB_XCNT(j)]); sum += c; cnt += (c > 0u) ? 1u : 0u; mine = (j == x) ? c : mine; }
        if (sum == G) break;
        __builtin_amdgcn_s_sleep(1);
        if ((++sp & 255u) == 0u) { if (xb_ld(&bar[XB_TMO])) break; if (sp > XB_SPIN_CAP) { atomicAdd(&bar[XB_TMO], 1u); break; } }
    }
    nloc = mine > 0u ? mine : 1u; nx = cnt > 0u ? cnt : 1u;
}

__device__ __forceinline__ void xcd_barrier(const XcdBarrier& b) {
    asm volatile("s_waitcnt vmcnt(0)" ::: "memory");
    __syncthreads();
    if (threadIdx.x == 0) {
        unsigned* bar = b.bar;
        __builtin_amdgcn_s_waitcnt(0);
        unsigned nloc = b.st[0], nx = b.st[1];
        if (nloc == 0u) { xcd_barrier_complete(bar, b.x, nloc, nx); b.st[0] = nloc; b.st[1] = nx; }
        const unsigned old = xb_add(&bar[XB_XSUB(b.x)], 1u);
        const unsigned gen = old / nloc;
        if (old + 1u == (gen + 1u) * nloc) {
            __builtin_amdgcn_fence(__ATOMIC_RELEASE, "agent");
            asm volatile("s_waitcnt vmcnt(0)" ::: "memory");
            const unsigned og = xb_add(&bar[XB_TOP], 1u);
            const unsigned tg = og / nx;
            if (og + 1u == (tg + 1u) * nx) xb_add(&bar[XB_TOPGEN], 1u);
            else XB_SPIN(xb_ld(&bar[XB_TOPGEN]) == tg, bar);
            __builtin_amdgcn_fence(__ATOMIC_ACQUIRE, "agent");
            xb_add(&bar[XB_XGEN(b.x)], 1u);
            asm volatile("s_waitcnt vmcnt(0)" ::: "memory");
        } else {
            XB_SPIN(xb_ld(&bar[XB_XGEN(b.x)]) == gen, bar);
            __builtin_amdgcn_fence(__ATOMIC_ACQUIRE, "agent");
            asm volatile("s_waitcnt vmcnt(0)" ::: "memory");
        }
    }
    __syncthreads();
}

struct Args { const float* in[18]; float* out; unsigned char* ws; int ph_lo, ph_hi, use_bar, pad; };
struct Frame {
    LAS unsigned char* lds;
    int tid, lane, wave, G, bid;
    unsigned char* ws;
    float* out;
};

__device__ __forceinline__ void p0_transpose_item(const float* W, int ldw, int K, bf16* WT, int n_dst0, int n_src0, int k0, LAS float* scr, int lane) {
#pragma unroll 8
    for (int i = 0; i < 32; ++i) { const int kk = 2 * i + (lane >> 5); scr[kk * 33 + (lane & 31)] = W[(size_t)(k0 + kk) * ldw + n_src0 + (lane & 31)]; }
    LDS_WAIT(); asm volatile("" ::: "memory");
    const int c = lane & 7;
#pragma unroll
    for (int j = 0; j < 4; ++j) { const int n = (lane >> 3) + 8 * j; const LAS float* s = scr + (8 * c) * 33 + n;
        v4u o; o.x = pk2(s[0 * 33], s[1 * 33]); o.y = pk2(s[2 * 33], s[3 * 33]); o.z = pk2(s[4 * 33], s[5 * 33]); o.w = pk2(s[6 * 33], s[7 * 33]);
        *(GAS v4u*)(WT + (size_t)(n_dst0 + n) * K + k0 + 8 * c) = o; }
    LDS_WAIT(); asm volatile("" ::: "memory");
}
__device__ __forceinline__ void p0_weights(const Args& A, Frame& F, int part, int wg_rank, int wg_count) {
    LAS float* scr = (LAS float*)(F.lds + F.wave * 16384);
    const int gw = wg_rank * NWAVES + F.wave, NGW = wg_count * NWAVES;
    constexpr int NPJ = 10240, I_IN = (D / 64) * (NPJ / 32), I_SQ = (D / 64) * (D / 32), I_PQ = (D / 64) * (2048 / 32);
    constexpr int NITEMS = I_IN + 3 * I_SQ + I_PQ;
    bf16* Win_t = (bf16*)(F.ws + WS_WIN); bf16* Wa_t = (bf16*)(F.ws + WS_WA); bf16* Wb_t = (bf16*)(F.ws + WS_WB); bf16* Wo_t = (bf16*)(F.ws + WS_WO); bf16* Wpq_t = (bf16*)(F.ws + WS_WPQ);
    const int it_lo = part == 0 ? 0 : (part == 1 ? I_IN : I_IN + 2 * I_SQ), it_hi = part == 0 ? I_IN : (part == 1 ? I_IN + 2 * I_SQ : NITEMS);
    for (int it = it_lo + gw; it < it_hi; it += NGW) {
        int r = it;
        if (r < I_IN) { const int nblk = NPJ / 32, kb = r / nblk, nb = r % nblk, n0 = 32 * nb; p0_transpose_item(A.in[2], IN_W, D, Win_t, n0, n0 + (n0 >= 3072 ? 16 : 0), 64 * kb, scr, F.lane); continue; } r -= I_IN;
        if (r < I_SQ) { const int kb = r / 32, nb = r % 32; p0_transpose_item(A.in[9], D, D, Wa_t, 32 * nb, 32 * nb, 64 * kb, scr, F.lane); continue; } r -= I_SQ;
        if (r < I_SQ) { const int kb = r / 32, nb = r % 32; p0_transpose_item(A.in[10], D, D, Wb_t, 32 * nb, 32 * nb, 64 * kb, scr, F.lane); continue; } r -= I_SQ;
        if (r < I_SQ) { const int kb = r / 32, nb = r % 32; p0_transpose_item(A.in[11], D, D, Wo_t, 32 * nb, 32 * nb, 64 * kb, scr, F.lane); continue; } r -= I_SQ;
        { const int kb = r / 64, nb = r % 64; p0_transpose_item(A.in[13], 2048, D, Wpq_t, 32 * nb, 32 * nb, 64 * kb, scr, F.lane); }
    }
    if (part == 0) {
    for (int i = wg_rank * NTHREADS + F.tid; i < 256 * (D / 2); i += wg_count * NTHREADS) { const int n = i / (D / 2), k2 = (i % (D / 2)) * 2;
        const unsigned v = n < 16 ? pk2(A.in[2][(size_t)k2 * IN_W + 3072 + n], A.in[2][(size_t)(k2 + 1) * IN_W + 3072 + n]) : 0u;
        *(unsigned*)(Win_t + (size_t)(NPJ + n) * D + k2) = v; }
    return; }
    if (part == 2) return;
    bf16* SKb = (bf16*)(F.ws + WS_SK);
    for (int i = wg_rank * NTHREADS + F.tid; i < 2 * 8 * 128 * 128 / 8; i += wg_count * NTHREADS) {
        const f32x4 a = ((const f32x4*)A.in[14])[2 * i], b = ((const f32x4*)A.in[14])[2 * i + 1];
        v4u o; o.x = pk2(a[0], a[1]); o.y = pk2(a[2], a[3]); o.z = pk2(b[0], b[1]); o.w = pk2(b[2], b[3]);
        ((v4u*)SKb)[i] = o; }
}
__device__ __forceinline__ void norm_rows(const Args& A, Frame& F, int seg, bf16* XN, int wg_rank, int wg_count) {
    f32x4 gn[4];
#pragma unroll
    for (int j = 0; j < 4; ++j) gn[j] = ((const f32x4*)A.in[1])[F.lane + 64 * j];
    for (int lr = wg_rank * NWAVES + F.wave; lr < MSEG; lr += wg_count * NWAVES) {
        const int g = (lr >> 11) * T + seg * TSEG + (lr & 2047);
        const f32x4* xr = (const f32x4*)(A.in[0] + (size_t)g * D) + F.lane;
        f32x4 v[4]; float ss = 0.f;
#pragma unroll
        for (int j = 0; j < 4; ++j) { v[j] = xr[64 * j]; ss += (v[j][0] * v[j][0] + v[j][1] * v[j][1]) + (v[j][2] * v[j][2] + v[j][3] * v[j][3]); }
        const float rstd = rsqrtf(wave_sum(ss) * (1.f / D) + EPS);
        unsigned long long* o8 = (unsigned long long*)(XN + (size_t)lr * D) + F.lane;
#pragma unroll
        for (int j = 0; j < 4; ++j) { v[j] = v[j] * rstd * gn[j]; o8[64 * j] = (unsigned long long)pk2(v[j][0], v[j][1]) | ((unsigned long long)pk2(v[j][2], v[j][3]) << 32); }
    }
}

constexpr int SC_RAW = 0, SC_GATE = 49152, SC_BA = 65536, SC_QK = 66048, SC_SS = 68096, SC_RED = 68224, SC_RED2 = 72320, SC_OBUF = 76416;
__device__ __forceinline__ void scan_post64(const Args& A, Frame& F, int g0, int h, const float* onorm, int act  , bf16* O) {
    LAS float* obuf = (LAS float*)(F.lds + SC_OBUF); const LAS bf16* gate = (const LAS bf16*)(F.lds + SC_GATE);
    const float w0 = onorm[F.lane], w1 = onorm[F.lane + 64];
    for (int tt = F.wave * 8; tt < F.wave * 8 + 8; ++tt) {
        const float o0 = obuf[tt * 128 + F.lane], o1 = obuf[tt * 128 + 64 + F.lane];
        const float rstd = rsqrtf(wave_sum(o0 * o0 + o1 * o1) * (1.f / 128.f) + EPS);
        const float g0v = bf2f(gate[tt * 128 + F.lane]), g1v = bf2f(gate[tt * 128 + 64 + F.lane]);
        const float a0 = g0v, a1 = g1v;
        bf16* orow = O + (size_t)(g0 + tt) * D + h * DH;
        orow[F.lane] = (bf16)f2bf(o0 * rstd * w0 * a0); orow[F.lane + 64] = (bf16)f2bf(o1 * rstd * w1 * a1);
    }
}
__device__ __forceinline__ void scanA_naive(const Args& A, Frame& F, int seg, int b, int h) {
    const int c = F.tid & 127, qd = F.tid >> 7, bh = b * NH + h;
    const bf16* P = (const bf16*)(F.ws + WS_P); const float* BA = (const float*)(F.ws + WS_BA);
    float* ST = (float*)(F.ws + WS_STATE) + (size_t)bh * DH * DH; float* HI = (float*)(F.ws + WS_HIST) + (size_t)bh * 9 * 128;
    LAS bf16* raw = (LAS bf16*)(F.lds + SC_RAW); LAS bf16* gateL = (LAS bf16*)(F.lds + SC_GATE); LAS float* baL = (LAS float*)(F.lds + SC_BA);
    LAS float* qk = (LAS float*)(F.lds + SC_QK); LAS float* ssL = (LAS float*)(F.lds + SC_SS); LAS float* red = (LAS float*)(F.lds + SC_RED); LAS float* red2 = (LAS float*)(F.lds + SC_RED2);
    LAS float* obuf = (LAS float*)(F.lds + SC_OBUF);
    float S[32];
#pragma unroll
    for (int i = 0; i < 32; ++i) S[i] = seg ? ST[(qd * 32 + i) * DH + c] : 0.f;
    float hq[3], hk[3], hv[3];
#pragma unroll
    for (int j = 0; j < 3; ++j) { hq[j] = seg ? HI[j * 128 + c] : 0.f; hk[j] = seg ? HI[(3 + j) * 128 + c] : 0.f; hv[j] = seg ? HI[(6 + j) * 128 + c] : 0.f; }
    float wq[4], wk[4], wv[4];
#pragma unroll
    for (int j = 0; j < 4; ++j) { wq[j] = A.in[3][j * 3072 + h * DH + c]; wk[j] = A.in[3][j * 3072 + 1024 + h * DH + c]; wv[j] = A.in[3][j * 3072 + 2048 + h * DH + c]; }
    const float nega = -__expf(A.in[4][h]), dtb = A.in[5][h];
#pragma unroll 1
    for (int t0 = 0; t0 < TSEG; t0 += 64) {
        const int lr0 = b * TSEG + t0, g0 = b * T + seg * TSEG + t0;
        __syncthreads();
#pragma unroll 2
        for (int e = F.tid; e < 64 * 64; e += NTHREADS) { const int row = e >> 6, sgc = e & 63, sg = sgc >> 4, ch = sgc & 15;
            const v4u val = *(const v4u*)(P + (size_t)(lr0 + row) * 8192 + sg * 1024 + h * DH + ch * 8);
            if (sg < 3) *(LAS v4u*)(raw + row * 384 + sg * 128 + ch * 8) = val; else *(LAS v4u*)(gateL + row * 128 + ch * 8) = val; }
        if (F.tid < 64) { const float be = BA[(size_t)(g0 + F.tid) * 16 + h], al = BA[(size_t)(g0 + F.tid) * 16 + 8 + h];
            baL[F.tid * 2] = sigmoid_f(be); baL[F.tid * 2 + 1] = __expf(nega * softplus_f(al + dtb)); }
        __syncthreads();
#pragma unroll 1
        for (int t = 0; t < 64; ++t) {
            const int par = t & 1;
            const float xq = bf2f(raw[t * 384 + c]), xk = bf2f(raw[t * 384 + 128 + c]), xv = bf2f(raw[t * 384 + 256 + c]);
            const float qc = silu_f(wq[0] * hq[0] + wq[1] * hq[1] + wq[2] * hq[2] + wq[3] * xq);
            const float kc = silu_f(wk[0] * hk[0] + wk[1] * hk[1] + wk[2] * hk[2] + wk[3] * xk);
            const float vc = silu_f(wv[0] * hv[0] + wv[1] * hv[1] + wv[2] * hv[2] + wv[3] * xv);
            hq[0] = hq[1]; hq[1] = hq[2]; hq[2] = xq; hk[0] = hk[1]; hk[1] = hk[2]; hk[2] = xk; hv[0] = hv[1]; hv[1] = hv[2]; hv[2] = xv;
            const float sq = wave_sum(qc * qc), sk = wave_sum(kc * kc);
            if (qd == 0) { qk[par * 256 + c] = qc; qk[par * 256 + 128 + c] = kc; }
            if (F.lane == 0) { ssL[par * 16 + F.wave * 2] = sq; ssL[par * 16 + F.wave * 2 + 1] = sk; }
            __syncthreads();
            const float rq = rsqrtf(ssL[par * 16 + 0] + ssL[par * 16 + 2] + EPS) * 0.08838834764831845f, rk = rsqrtf(ssL[par * 16 + 1] + ssL[par * 16 + 3] + EPS);
            float skp = 0.f;
#pragma unroll
            for (int i4 = 0; i4 < 8; ++i4) { const f32x4 kk = *(const LAS f32x4*)(qk + par * 256 + 128 + qd * 32 + 4 * i4);
                skp += (kk[0] * S[4 * i4] + kk[1] * S[4 * i4 + 1]) + (kk[2] * S[4 * i4 + 2] + kk[3] * S[4 * i4 + 3]); if ((i4 & 3) == 3) asm volatile("" ::: "memory"); }
            skp *= rk;
            red[par * 512 + qd * 128 + c] = skp;
            __syncthreads();
            const float Sk = (red[par * 512 + c] + red[par * 512 + 128 + c]) + (red[par * 512 + 256 + c] + red[par * 512 + 384 + c]);
            const float beta = baL[t * 2], a = baL[t * 2 + 1];
            const float dl = beta * (vc - a * Sk) * rk;
            float op = 0.f;
#pragma unroll
            for (int i4 = 0; i4 < 8; ++i4) { const f32x4 kk = *(const LAS f32x4*)(qk + par * 256 + 128 + qd * 32 + 4 * i4), qq = *(const LAS f32x4*)(qk + par * 256 + qd * 32 + 4 * i4);
#pragma unroll
                for (int j = 0; j < 4; ++j) { S[4 * i4 + j] = a * S[4 * i4 + j] + kk[j] * dl; op += qq[j] * S[4 * i4 + j]; }
                if ((i4 & 1) == 1) asm volatile("" ::: "memory"); }
            red2[par * 512 + qd * 128 + c] = op * rq;
            __syncthreads();
            if (qd == 0) obuf[t * 128 + c] = (red2[par * 512 + c] + red2[par * 512 + 128 + c]) + (red2[par * 512 + 256 + c] + red2[par * 512 + 384 + c]);
        }
        __syncthreads();
        scan_post64(A, F, g0, h, A.in[6], 0, (bf16*)(F.ws + WS_OA));
    }
#pragma unroll
    for (int i = 0; i < 32; ++i) ST[(qd * 32 + i) * DH + c] = S[i];
    if (qd == 0) {
#pragma unroll
        for (int j = 0; j < 3; ++j) { HI[j * 128 + c] = hq[j]; HI[(3 + j) * 128 + c] = hk[j]; HI[(6 + j) * 128 + c] = hv[j]; } }
}
__device__ __forceinline__ void scanB_naive(const Args& A, Frame& F, int seg, int b, int h) {
    const int c = F.tid & 127, qd = F.tid >> 7, bh = b * NH + h;
    const bf16* P = (const bf16*)(F.ws + WS_P);
    float* ST = (float*)(F.ws + WS_STATE) + (size_t)(16 + bh) * DH * DH;
    LAS bf16* raw = (LAS bf16*)(F.lds + SC_RAW); LAS bf16* gateL = (LAS bf16*)(F.lds + SC_GATE);
    LAS float* fq = (LAS float*)(F.lds + SC_QK); LAS float* red = (LAS float*)(F.lds + SC_RED); LAS float* obuf = (LAS float*)(F.lds + SC_OBUF);
    float S[32];
#pragma unroll
    for (int i = 0; i < 32; ++i) S[i] = seg ? ST[(qd * 32 + i) * DH + c] : 0.f;
    const float l0 = A.in[7][h * DH + c], l1 = A.in[7][1024 + h * DH + c];
    const float lb = 1.f / (1.f + __expf(l1 - l0));
#pragma unroll 1
    for (int t0 = 0; t0 < TSEG; t0 += 64) {
        const int lr0 = b * TSEG + t0, g0 = b * T + seg * TSEG + t0;
        __syncthreads();
#pragma unroll 2
        for (int e = F.tid; e < 64 * 64; e += NTHREADS) { const int row = e >> 6, sgc = e & 63, sg = sgc >> 4, ch = sgc & 15;
            const v4u val = *(const v4u*)(P + (size_t)(lr0 + row) * 8192 + (4 + sg) * 1024 + h * DH + ch * 8);
            if (sg < 3) *(LAS v4u*)(raw + row * 384 + sg * 128 + ch * 8) = val; else *(LAS v4u*)(gateL + row * 128 + ch * 8) = val; }
        __syncthreads();
#pragma unroll 1
        for (int t = 0; t < 64; ++t) {
            const int par = t & 1;
            const float f = lb + (1.f - lb) * sigmoid_f(bf2f(raw[t * 384 + c])), v = bf2f(raw[t * 384 + 128 + c]), q = silu_f(bf2f(raw[t * 384 + 256 + c]));
            if (qd == 0) { fq[par * 256 + c] = f; fq[par * 256 + 128 + c] = q; }
            __syncthreads();
            float op = 0.f;
#pragma unroll
            for (int i4 = 0; i4 < 8; ++i4) { const f32x4 ff = *(const LAS f32x4*)(fq + par * 256 + qd * 32 + 4 * i4), qq = *(const LAS f32x4*)(fq + par * 256 + 128 + qd * 32 + 4 * i4);
#pragma unroll
                for (int j = 0; j < 4; ++j) { S[4 * i4 + j] = ff[j] * S[4 * i4 + j] + (1.f - ff[j]) * v; op += qq[j] * S[4 * i4 + j]; }
                if ((i4 & 1) == 1) asm volatile("" ::: "memory"); }
            red[par * 512 + qd * 128 + c] = op;
            __syncthreads();
            if (qd == 0) obuf[t * 128 + c] = (red[par * 512 + c] + red[par * 512 + 128 + c]) + (red[par * 512 + 256 + c] + red[par * 512 + 384 + c]);
        }
        __syncthreads();
        scan_post64(A, F, g0, h, A.in[8], 1, (bf16*)(F.ws + WS_OB));
    }
#pragma unroll
    for (int i = 0; i < 32; ++i) ST[(qd * 32 + i) * DH + c] = S[i];
}

__device__ __forceinline__ void f3_h2(const Args& A, Frame& F) {
    bf16* H2 = (bf16*)(F.ws + WS_H2);
    f32x4 gn[4];
#pragma unroll
    for (int j = 0; j < 4; ++j) gn[j] = ((const f32x4*)A.in[12])[F.lane + 64 * j];
    for (int r = F.bid * NWAVES + F.wave; r < M; r += F.G * NWAVES) {
        const f32x4* xr = (const f32x4*)(F.out + (size_t)r * D) + F.lane;
        f32x4 v[4]; float ss = 0.f;
#pragma unroll
        for (int j = 0; j < 4; ++j) { v[j] = xr[64 * j]; ss += (v[j][0] * v[j][0] + v[j][1] * v[j][1]) + (v[j][2] * v[j][2] + v[j][3] * v[j][3]); }
        const float rstd = rsqrtf(wave_sum(ss) * (1.f / D) + EPS);
        unsigned long long* o8 = (unsigned long long*)(H2 + (size_t)r * D) + F.lane;
#pragma unroll
        for (int j = 0; j < 4; ++j) { v[j] = v[j] * rstd * gn[j]; o8[64 * j] = (unsigned long long)pk2(v[j][0], v[j][1]) | ((unsigned long long)pk2(v[j][2], v[j][3]) << 32); }
    }
}

constexpr float EU_SCALE = 128.f, EV_SCALE = 16.f;
__device__ __forceinline__ unsigned pk4_fp8(const f32x4 v, float s) { int w = 0; w = __builtin_amdgcn_cvt_pk_fp8_f32(v[0] * s, v[1] * s, w, false); w = __builtin_amdgcn_cvt_pk_fp8_f32(v[2] * s, v[3] * s, w, true); return (unsigned)w; }
__device__ __forceinline__ void convert_experts(const Args& A, Frame& F, int wg_rank, int wg_count) {
    v4u* EU = (v4u*)(F.ws + WS_EU); v4u* EV = (v4u*)(F.ws + WS_EV);
    for (int i = wg_rank * NTHREADS + F.tid; i < NEXP * D / 16; i += wg_count * NTHREADS) {
        const f32x4* pu = (const f32x4*)A.in[15] + 4 * (size_t)i; const f32x4* pv = (const f32x4*)A.in[16] + 4 * (size_t)i;
        const f32x4 a0 = pu[0], a1 = pu[1], a2 = pu[2], a3 = pu[3], c0 = pv[0], c1 = pv[1], c2 = pv[2], c3 = pv[3];
        EU[i] = (v4u){pk4_fp8(a0, EU_SCALE), pk4_fp8(a1, EU_SCALE), pk4_fp8(a2, EU_SCALE), pk4_fp8(a3, EU_SCALE)};
        EV[i] = (v4u){pk4_fp8(c0, EV_SCALE), pk4_fp8(c1, EV_SCALE), pk4_fp8(c2, EV_SCALE), pk4_fp8(c3, EV_SCALE)}; }
}

__device__ __forceinline__ void wave_argmax(float& v, int& i) {
#pragma unroll
    for (int o = 32; o >= 1; o >>= 1) { const float ov = __shfl_xor(v, o); const int oi = __shfl_xor(i, o); if (ov > v || (ov == v && oi < i)) { v = ov; i = oi; } }
}
__device__ __forceinline__ void f5_topk_naive(const Args& A, Frame& F) {
    const bf16* SKb = (const bf16*)(F.ws + WS_SK); const bf16* Q2 = (const bf16*)(F.ws + WS_Q2);
    int* IDX = (int*)(F.ws + WS_IDX); float* GATE = (float*)(F.ws + WS_GATE);
    LAS unsigned char* skl = F.lds; LAS unsigned char* qa = F.lds + 69632 + F.wave * 512;
    for (int item = F.bid; item < 8 * 32; item += F.G) {
        const int h = item & 7, grp = item >> 3;
        __syncthreads();
        for (int e = F.tid; e < 2 * 128 * 16; e += NTHREADS) { const int p = e >> 11, k = (e >> 4) & 127, ch = e & 15;
            *(LAS v4u*)(skl + p * 34816 + k * 272 + ch * 16) = *(const v4u*)(SKb + ((size_t)(p * 8 + h) * 128 + k) * 128 + ch * 8); }
        __syncthreads();
        for (int tt = 0; tt < 64; ++tt) {
            const int t = grp * 512 + F.wave * 64 + tt;
            if (F.lane < 32) *(LAS v4u*)(qa + F.lane * 16) = *(const v4u*)(Q2 + (size_t)t * 2048 + h * 256 + F.lane * 8);
            LDS_WAIT();
            float tops[2]; int topi[2];
#pragma unroll
            for (int p = 0; p < 2; ++p) {
                float s0 = 0.f, s1 = 0.f;
#pragma unroll 4
                for (int ch = 0; ch < 16; ++ch) {
                    const v4u qv = *(const LAS v4u*)(qa + p * 256 + ch * 16);
                    const v4u k0 = *(const LAS v4u*)(skl + p * 34816 + F.lane * 272 + ch * 16), k1 = *(const LAS v4u*)(skl + p * 34816 + (F.lane + 64) * 272 + ch * 16);
#pragma unroll
                    for (int j = 0; j < 4; ++j) { const float ql = blo(qv[j]), qh = bhi(qv[j]); s0 += ql * blo(k0[j]) + qh * bhi(k0[j]); s1 += ql * blo(k1[j]) + qh * bhi(k1[j]); }
                }
                float tv = -3.0e38f; int ti = 0;
                for (int r = 0; r < 16; ++r) {
                    float bv = s0 >= s1 ? s0 : s1; int bi = s0 >= s1 ? F.lane : F.lane + 64;
                    wave_argmax(bv, bi);
                    if (F.lane == r) { tv = bv; ti = bi; }
                    if (bi == F.lane) s0 = -3.0e38f; if (bi == F.lane + 64) s1 = -3.0e38f;
                }
                tops[p] = tv; topi[p] = ti;
            }
            float cand[4];
#pragma unroll
            for (int e = 0; e < 4; ++e) cand[e] = __shfl(tops[0], F.lane >> 2) + __shfl(tops[1], (F.lane & 3) * 4 + e);
            float bs = -3.0e38f; int bc = 0;
            for (int r = 0; r < 16; ++r) {
                float bv = cand[0]; int bi = F.lane * 4;
#pragma unroll
                for (int e = 1; e < 4; ++e) if (cand[e] > bv) { bv = cand[e]; bi = F.lane * 4 + e; }
                wave_argmax(bv, bi);
                if (F.lane == r) { bs = bv; bc = bi; }
#pragma unroll
                for (int e = 0; e < 4; ++e) if (bi == F.lane * 4 + e) cand[e] = -3.0e38f;
            }
            const float mx = __shfl(bs, 0);
            const float ex = F.lane < 16 ? __expf(bs - mx) : 0.f;
            const float sum = wave_sum(ex);
            const int i0 = __shfl(topi[0], bc >> 4), i1 = __shfl(topi[1], bc & 15);
            if (F.lane < 16) { IDX[(size_t)t * 128 + h * 16 + F.lane] = i0 * 128 + i1; GATE[(size_t)t * 128 + h * 16 + F.lane] = ex / sum; }
        }
    }
}

__device__ __forceinline__ void f6_peer_naive(const Args& A, Frame& F) {
    const int* IDX = (const int*)(F.ws + WS_IDX); const float* GATE = (const float*)(F.ws + WS_GATE);
    f32x4 g2[4], gf[4];
#pragma unroll
    for (int j = 0; j < 4; ++j) { g2[j] = ((const f32x4*)A.in[12])[F.lane + 64 * j]; gf[j] = ((const f32x4*)A.in[17])[F.lane + 64 * j]; }
    for (int t = F.bid * NWAVES + F.wave; t < M; t += F.G * NWAVES) {
        f32x4* xr = (f32x4*)(F.out + (size_t)t * D) + F.lane;
        f32x4 x1[4], hn[4], y[4]; float ss = 0.f;
#pragma unroll
        for (int j = 0; j < 4; ++j) { x1[j] = xr[64 * j]; ss += (x1[j][0] * x1[j][0] + x1[j][1] * x1[j][1]) + (x1[j][2] * x1[j][2] + x1[j][3] * x1[j][3]); y[j] = (f32x4){0.f, 0.f, 0.f, 0.f}; }
        const float rstd = rsqrtf(wave_sum(ss) * (1.f / D) + EPS);
#pragma unroll
        for (int j = 0; j < 4; ++j) hn[j] = x1[j] * rstd * g2[j];
        const int ie0 = IDX[(size_t)t * 128 + F.lane], ie1 = IDX[(size_t)t * 128 + 64 + F.lane];
        const float ga0 = GATE[(size_t)t * 128 + F.lane], ga1 = GATE[(size_t)t * 128 + 64 + F.lane];
#pragma unroll 2
        for (int k = 0; k < 128; ++k) {
            const int e = __builtin_amdgcn_readlane(k < 64 ? ie0 : ie1, k & 63);
            const float gk = __uint_as_float(__builtin_amdgcn_readlane(__float_as_uint(k < 64 ? ga0 : ga1), k & 63));
            const f32x4* ur = (const f32x4*)(A.in[15] + (size_t)e * D) + F.lane; const f32x4* vr = (const f32x4*)(A.in[16] + (size_t)e * D) + F.lane;
            f32x4 u[4], vv[4]; float d = 0.f;
#pragma unroll
            for (int j = 0; j < 4; ++j) { u[j] = ur[64 * j]; vv[j] = vr[64 * j]; }
#pragma unroll
            for (int j = 0; j < 4; ++j) d += (hn[j][0] * u[j][0] + hn[j][1] * u[j][1]) + (hn[j][2] * u[j][2] + hn[j][3] * u[j][3]);
            d = wave_sum(d);
            const float coef = gk * 0.5f * d * (1.f + erff(d * 0.70710678118654752f));
#pragma unroll
            for (int j = 0; j < 4; ++j) y[j] = y[j] + vv[j] * coef;
        }
        float s2 = 0.f;
#pragma unroll
        for (int j = 0; j < 4; ++j) { x1[j] = x1[j] + y[j]; s2 += (x1[j][0] * x1[j][0] + x1[j][1] * x1[j][1]) + (x1[j][2] * x1[j][2] + x1[j][3] * x1[j][3]); }
        const float r2 = rsqrtf(wave_sum(s2) * (1.f / D) + EPS);
#pragma unroll
        for (int j = 0; j < 4; ++j) xr[64 * j] = x1[j] * r2 * gf[j];
    }
}

typedef float f32x2w __attribute__((ext_vector_type(2)));
__device__ __forceinline__ void sort128(unsigned& a, unsigned& b, int lane) {
#pragma unroll
    for (int k = 2; k <= 128; k <<= 1) {
#pragma unroll
        for (int j = k >> 1; j > 0; j >>= 1) {
            if (j == 64) { const unsigned lo = a < b ? a : b, hi = a < b ? b : a; a = lo; b = hi; }
            else {
                const unsigned oa = __shfl_xor(a, j), ob = __shfl_xor(b, j);
                const bool lower = (lane & j) == 0;
                const bool asc_a = (k == 128) ? true : ((lane & k) == 0), asc_b = (k == 128) ? true : ((lane & k) == 0);
                const bool aa = (k == 64) ? true : asc_a, ab = (k == 64) ? false : asc_b;
                const unsigned mna = a < oa ? a : oa, mxa = a < oa ? oa : a, mnb = b < ob ? b : ob, mxb = b < ob ? ob : b;
                a = (lower == aa) ? mna : mxa; b = (lower == ab) ? mnb : mxb;
            }
        }
    }
}
__device__ __forceinline__ void f6_load4(__amdgpu_buffer_rsrc_t TB, unsigned lb, unsigned key, int lbase, v4u (&r)[4], unsigned emask = 0x3fffu) {
#pragma unroll
    for (int k = 0; k < 4; ++k) { const unsigned e = ((unsigned)__builtin_amdgcn_readlane((int)key, lbase + k) >> 16) & emask; r[k] = __builtin_amdgcn_raw_buffer_load_b128(TB, (int)lb, (int)(e * (unsigned)D), 0); }
}
__device__ __forceinline__ float gelu_as(float v) {
    const float t = __builtin_amdgcn_rcpf(fabsf(v) * 0.2316418882f + 1.0f);
    float q = t * 0.5307027145f + (-0.7265760135f); q = q * t + 0.7107068705f; q = q * t + (-0.142248368f); q = q * t + 0.127414796f; q = q * t;
    const float m = v * (q * __builtin_amdgcn_exp2f(v * v * (-0.72134752044f)));
    return v < 0.f ? m : v - m;
}
__device__ __forceinline__ float f6_row16_sum(float v) {
    v += __uint_as_float(__builtin_amdgcn_update_dpp(0, __float_as_uint(v), 0xB1, 0xF, 0xF, true));
    v += __uint_as_float(__builtin_amdgcn_update_dpp(0, __float_as_uint(v), 0x4E, 0xF, 0xF, true));
    v += __uint_as_float(__builtin_amdgcn_update_dpp(0, __float_as_uint(v), 0x141, 0xF, 0xF, true));
    v += __uint_as_float(__builtin_amdgcn_update_dpp(0, __float_as_uint(v), 0x140, 0xF, 0xF, true));
    return v;
}
__device__ __forceinline__ float f6_coef4(const v4u (&u)[4], const LAS float* hxl, unsigned key, int lbase, int lane) {
    float hx[16];
#pragma unroll
    for (int j = 0; j < 4; ++j) { const f32x4 t = *(const LAS f32x4*)(hxl + 4 * j); hx[4 * j] = t[0]; hx[4 * j + 1] = t[1]; hx[4 * j + 2] = t[2]; hx[4 * j + 3] = t[3]; }
    float d[4];
#pragma unroll
    for (int k = 0; k < 4; ++k) { float s0 = 0.f, s1 = 0.f;
#pragma unroll
        for (int j = 0; j < 4; ++j) { const f32x2w lo = __builtin_amdgcn_cvt_pk_f32_fp8((int)u[k][j], false), hi = __builtin_amdgcn_cvt_pk_f32_fp8((int)u[k][j], true);
            s0 += lo.x * hx[4 * j] + hi.x * hx[4 * j + 2]; s1 += lo.y * hx[4 * j + 1] + hi.y * hx[4 * j + 3]; }
        d[k] = s0 + s1; }
    float s[4];
#pragma unroll
    for (int k = 0; k < 4; ++k) s[k] = f6_row16_sum(d[k]);
    float u2[2];
#pragma unroll
    for (int k = 0; k < 2; ++k) { const auto w = __builtin_amdgcn_permlane32_swap(__float_as_uint(s[k]), __float_as_uint(s[k + 2]), false, false);
        u2[k] = __uint_as_float(w[0]) + __uint_as_float(w[1]); }
    float r1;
    { const auto w = __builtin_amdgcn_permlane16_swap(__float_as_uint(u2[0]), __float_as_uint(u2[1]), false, false); r1 = __uint_as_float(w[0]) + __uint_as_float(w[1]); }
    r1 *= (1.f / EU_SCALE);
    float gk = 0.f;
#pragma unroll
    for (int k = 0; k < 4; ++k) { const float gg = __uint_as_float((unsigned)__builtin_amdgcn_readlane((int)key, lbase + k) << 16); gk = ((lane >> 4) == k) ? gg : gk; }
    return gk * gelu_as(r1) * (1.f / EV_SCALE);
}
__device__ __forceinline__ void f6_acc4(const v4u (&v)[4], float (&y)[16], float cf, int lbase) {
#pragma unroll
    for (int k = 0; k < 4; ++k) { const float c = __uint_as_float(__builtin_amdgcn_readlane(__float_as_uint(cf), lbase + k));
#pragma unroll
        for (int j = 0; j < 4; ++j) { const f32x2w lo = __builtin_amdgcn_cvt_pk_f32_fp8((int)v[k][j], false), hi = __builtin_amdgcn_cvt_pk_f32_fp8((int)v[k][j], true);
            y[4 * j] += c * lo.x; y[4 * j + 1] += c * lo.y; y[4 * j + 2] += c * hi.x; y[4 * j + 3] += c * hi.y; } }
}
__device__ __forceinline__ void f6_peer(const Args& A, Frame& F, bool dry, bool novalu = false, unsigned emask = 0x3fffu) {
    const GAS int* IDX = (const GAS int*)(F.ws + WS_IDX); const GAS float* GATE = (const GAS float*)(F.ws + WS_GATE);
    const __amdgpu_buffer_rsrc_t EU = __builtin_amdgcn_make_buffer_rsrc((void*)(F.ws + WS_EU), 0, NEXP * D, 0x00020000), EV = __builtin_amdgcn_make_buffer_rsrc((void*)(F.ws + WS_EV), 0, NEXP * D, 0x00020000);
    const int lane = F.lane, l16 = lane * 16; const unsigned lb = (unsigned)l16;
    LAS float* hxw = (LAS float*)(F.lds + F.wave * 16384);
#pragma unroll 1
    for (int base = (F.bid * NWAVES + F.wave) * 4; base < M; base += F.G * NWAVES * 4) {
        unsigned K0[4], K1[4];
#pragma unroll
        for (int q = 0; q < 4; ++q) { const int t = base + q; const GAS v4u* xp = (const GAS v4u*)((const GAS bf16*)F.out + (size_t)t * (2 * D) + D + l16);
            f32x4 a[4]; float ss = 0.f;
            { const v4u w0 = xp[0], w1 = xp[1];
              a[0] = (f32x4){blo(w0[0]), bhi(w0[0]), blo(w0[1]), bhi(w0[1])}; a[1] = (f32x4){blo(w0[2]), bhi(w0[2]), blo(w0[3]), bhi(w0[3])};
              a[2] = (f32x4){blo(w1[0]), bhi(w1[0]), blo(w1[1]), bhi(w1[1])}; a[3] = (f32x4){blo(w1[2]), bhi(w1[2]), blo(w1[3]), bhi(w1[3])}; }
#pragma unroll
            for (int j = 0; j < 4; ++j) ss += (a[j][0] * a[j][0] + a[j][1] * a[j][1]) + (a[j][2] * a[j][2] + a[j][3] * a[j][3]);
            const float rstd = rsqrtf(wave_sum(ss) * (1.f / D) + EPS);
#pragma unroll
            for (int j = 0; j < 4; ++j) { const f32x4 g2 = *(const f32x4*)(A.in[12] + l16 + 4 * j); f32x4 hv;
#pragma unroll
                for (int e = 0; e < 4; ++e) hv[e] = bf2f((unsigned short)f2bf(a[j][e] * rstd * g2[e]));
                *(LAS f32x4*)(hxw + q * 1024 + l16 + 4 * j) = hv; }
            unsigned ka = ((unsigned)IDX[(size_t)t * 128 + lane] << 16) | f2bf(GATE[(size_t)t * 128 + lane]), kb = ((unsigned)IDX[(size_t)t * 128 + 64 + lane] << 16) | f2bf(GATE[(size_t)t * 128 + 64 + lane]);
            sort128(ka, kb, lane);
            K0[q] = ka; K1[q] = kb; }
        LDS_WAIT();
#define F6_KEY(q_, g_) ((g_) < 16 ? K0[q_] : K1[q_])
#define F6_LB(g_) (((g_) & 15) * 4)
        float C0[4], C1[4];
#pragma unroll
        for (int q = 0; q < 4; ++q) { C0[q] = 0.f; C1[q] = 0.f; }
        { v4u ua[4], ub[4];
          f6_load4(EU, lb, K0[0], 0, ua, emask); f6_load4(EU, lb, K0[1], 0, ub, emask);
#pragma unroll 1
          for (int g = 0; g < ((emask == 1u) ? 0 : 32); ++g) {
#pragma unroll
              for (int q = 0; q < 4; ++q) {
                  const int lbase = F6_LB(g);
                  const float cf = f6_coef4((q & 1) ? ub : ua, hxw + q * 1024 + l16, F6_KEY(q, g), lbase, lane);
                  { const int gn = g + (q >= 2 ? 1 : 0), qn = (q + 2) & 3;
                    if (gn < 32) { if (q & 1) f6_load4(EU, lb, F6_KEY(qn, gn), F6_LB(gn), ub, emask); else f6_load4(EU, lb, F6_KEY(qn, gn), F6_LB(gn), ua, emask); } }
                  float mine = 0.f;
#pragma unroll
                  for (int k = 0; k < 4; ++k) { const float ck = __uint_as_float(__builtin_amdgcn_readlane(__float_as_uint(cf), 16 * k)); mine = (lane == lbase + k) ? ck : mine; }
                  const bool take = (unsigned)(lane - lbase) < 4u;
                  if (g < 16) C0[q] = take ? mine : C0[q]; else C1[q] = take ? mine : C1[q];
              }
          } }
        float y[4][16];
#pragma unroll
        for (int q = 0; q < 4; ++q)
#pragma unroll
            for (int j = 0; j < 16; ++j) y[q][j] = 0.f;
        { v4u va[4], vb[4];
          f6_load4(EV, lb, K0[0], 0, va, emask); f6_load4(EV, lb, K0[1], 0, vb, emask);
#pragma unroll 1
          for (int g = 0; g < ((emask == 1u || emask == 3u) ? 0 : 32); ++g) {
#pragma unroll
              for (int q = 0; q < 4; ++q) {
                  const int lbase = F6_LB(g);
                  if (!novalu) f6_acc4((q & 1) ? vb : va, y[q], g < 16 ? C0[q] : C1[q], lbase);
                  else { if (q & 1) { asm volatile("" :: "v"(vb[0]), "v"(vb[1]), "v"(vb[2]), "v"(vb[3])); } else { asm volatile("" :: "v"(va[0]), "v"(va[1]), "v"(va[2]), "v"(va[3])); } }
                  { const int gn = g + (q >= 2 ? 1 : 0), qn = (q + 2) & 3;
                    if (gn < 32) { if (q & 1) f6_load4(EV, lb, F6_KEY(qn, gn), F6_LB(gn), vb, emask); else f6_load4(EV, lb, F6_KEY(qn, gn), F6_LB(gn), va, emask); } }
              }
          } }
#undef F6_KEY
#undef F6_LB
#pragma unroll
        for (int q = 0; q < 4; ++q) { const int t = base + q; float* xr = F.out + (size_t)t * D + l16; float s2 = 0.f;
            { const GAS v4u* xp = (const GAS v4u*)((const GAS bf16*)F.out + (size_t)t * (2 * D) + D + l16); const v4u w0 = xp[0], w1 = xp[1];
#pragma unroll
              for (int e = 0; e < 4; ++e) { y[q][2 * e] += blo(w0[e]); y[q][2 * e + 1] += bhi(w0[e]); y[q][8 + 2 * e] += blo(w1[e]); y[q][8 + 2 * e + 1] += bhi(w1[e]); } }
#pragma unroll
            for (int j = 0; j < 16; ++j) s2 += y[q][j] * y[q][j];
            const float r2 = rsqrtf(wave_sum(s2) * (1.f / D) + EPS);
            float* xo = dry ? (float*)(F.ws + WS_Q2) + (size_t)t * D + l16 : xr;
#pragma unroll
            for (int j = 0; j < 4; ++j) { const f32x4 gf = *(const f32x4*)(A.in[17] + l16 + 4 * j);
                *(f32x4*)(xo + 4 * j) = (f32x4){y[q][4 * j] * r2 * gf[0], y[q][4 * j + 1] * r2 * gf[1], y[q][4 * j + 2] * r2 * gf[2], y[q][4 * j + 3] * r2 * gf[3]}; } }
        LDS_WAIT();
    }
}

typedef float f32x16 __attribute__((ext_vector_type(16)));
typedef float f32x2v __attribute__((ext_vector_type(2)));
typedef short bf16x8 __attribute__((ext_vector_type(8)));
#define MFMA32(a, b, c) __builtin_amdgcn_mfma_f32_32x32x16_bf16((a), (b), (c), 0, 0, 0)
__device__ __forceinline__ unsigned pkbf(float lo, float hi) { f32x2v v; v.x = lo; v.y = hi; return __builtin_bit_cast(unsigned, __builtin_convertvector(v, bf2_t)); }
__device__ __forceinline__ bf16x8 pack_step(const f32x16& x, int s) {
    v4u p; p.x = pkbf(x[8 * s], x[8 * s + 1]); p.y = pkbf(x[8 * s + 2], x[8 * s + 3]); p.z = pkbf(x[8 * s + 4], x[8 * s + 5]); p.w = pkbf(x[8 * s + 6], x[8 * s + 7]);
    return __builtin_bit_cast(bf16x8, p);
}
__device__ __forceinline__ int crow(int reg, int hh) { return (reg & 3) + 8 * (reg >> 2) + 4 * hh; }
__device__ __forceinline__ int toff(int row, int col) { return row * 256 + (((col >> 3) ^ (row & 15)) << 4) + ((col & 7) << 1); }

constexpr int NC = 32, NCH = TSEG / NC;
constexpr int NBLK_A = 36, NBLK_B = 28, REC_A = NBLK_A * 1024, REC_B = NBLK_B * 1024;
constexpr size_t WS_RECA = WS_PREP, WS_RECB = WS_PREP + (size_t)16 * NCH * REC_A;
static_assert(WS_RECB + (size_t)16 * NCH * REC_B <= 256 * MiB, "prep records fit");
constexpr int PW_BYTES = 16896;

__device__ __forceinline__ void prepA_chunk(const Args& A, Frame& F, int seg, int b, int h, int n, LAS unsigned char* wl) {
    int lane_ = F.lane; asm volatile("" : "+v"(lane_));
    const int lane = lane_, r = lane & 31, hh = lane >> 5, bh = b * NH + h;
    const GAS bf16* P = (const GAS bf16*)(F.ws + WS_P);
    GAS unsigned char* rec = (GAS unsigned char*)(F.ws + WS_RECA) + (size_t)(bh * NCH + n) * REC_A;
    GAS unsigned* histw = (GAS unsigned*)(F.ws + WS_HIST) + (size_t)((seg & 1) * 16 + bh) * 3 * 192;
    const GAS unsigned* histr = (const GAS unsigned*)(F.ws + WS_HIST) + (size_t)(((seg + 1) & 1) * 16 + bh) * 3 * 192;
    LAS unsigned char* QT = wl; LAS unsigned char* KT_ = wl + 8192; LAS float* sc = (LAS float*)(wl + 16384);
    const int t0 = n * NC, lr0 = b * TSEG + t0, g0 = b * T + seg * TSEG + t0;
#pragma unroll
    for (int X = 0; X < 2; ++X) {
        const int cb = X * 1024 + h * DH + 2 * lane;
        float w0[4], w1[4];
#pragma unroll
        for (int j = 0; j < 4; ++j) { w0[j] = A.in[3][j * 3072 + cb]; w1[j] = A.in[3][j * 3072 + cb + 1]; }
        unsigned raw[35]; unsigned voff = (unsigned)((lr0 - 3) * 16384 + cb * 2);
#pragma unroll
        for (int i = 0; i < 35; ++i) {
            if (i < 3 && n == 0) raw[i] = seg ? histr[i * 192 + X * 64 + lane] : 0u;
            else raw[i] = *(const GAS unsigned*)((const GAS unsigned char*)P + voff);
            voff += 16384u; asm volatile("" : "+v"(voff));
        }
        if (n == NCH - 1) {
#pragma unroll
            for (int i = 0; i < 3; ++i) histw[i * 192 + X * 64 + lane] = raw[32 + i]; }
        LAS unsigned char* tile = X ? KT_ : QT;
#pragma unroll
        for (int t = 0; t < 32; ++t) {
            const float y0 = w0[0] * blo(raw[t]) + w0[1] * blo(raw[t + 1]) + w0[2] * blo(raw[t + 2]) + w0[3] * blo(raw[t + 3]);
            const float y1 = w1[0] * bhi(raw[t]) + w1[1] * bhi(raw[t + 1]) + w1[2] * bhi(raw[t + 2]) + w1[3] * bhi(raw[t + 3]);
            *(LAS unsigned*)(tile + toff(t, 2 * lane)) = pkbf(silu_f(y0), silu_f(y1));
        }
    }
    float beta, G;
    { const GAS float* BA = (const GAS float*)(F.ws + WS_BA) + (size_t)(g0 + r) * 16;
      beta = sigmoid_f(BA[h]); G = -fexp(A.in[4][h]) * softplus_f(BA[8 + h] + A.in[5][h]);
#pragma unroll
      for (int o = 1; o < 32; o <<= 1) { const float up = __shfl_up(G, o, 32); if (r >= o) G += up; } }
    const float Glast = __shfl(G, 31, 32);
    if (lane < 32) { sc[r] = beta; sc[32 + r] = G; }
    LDS_WAIT();
    __builtin_amdgcn_sched_barrier(0);
    f32x16 KK, QKT, QQ;
#pragma unroll
    for (int i = 0; i < 16; ++i) { KK[i] = 0.f; QKT[i] = 0.f; QQ[i] = 0.f; }
#pragma unroll
    for (int kt = 0; kt < 8; ++kt) {
        const bf16x8 ak = *(const LAS bf16x8*)(KT_ + toff(r, 16 * kt + 8 * hh)), aq = *(const LAS bf16x8*)(QT + toff(r, 16 * kt + 8 * hh));
        KK = MFMA32(ak, ak, KK); QKT = MFMA32(ak, aq, QKT); QQ = MFMA32(aq, aq, QQ);
    }
    { float dk = 0.f, dq = 0.f;
#pragma unroll
      for (int reg = 0; reg < 16; ++reg) if (crow(reg, hh) == r) { dk = KK[reg]; dq = QQ[reg]; }
      if (hh == ((r >> 2) & 1)) { sc[64 + r] = rsqrtf(dk + EPS); sc[96 + r] = rsqrtf(dq + EPS) * 0.08838834764831845f; } }
    LDS_WAIT();
    const float rk_own = sc[64 + r], rq_own = sc[96 + r];
    f32x16 AK, X;
#pragma unroll
    for (int g4 = 0; g4 < 4; ++g4) {
        const f32x4 be4 = *(const LAS f32x4*)(sc + 8 * g4 + 4 * hh), G4 = *(const LAS f32x4*)(sc + 32 + 8 * g4 + 4 * hh), rk4 = *(const LAS f32x4*)(sc + 64 + 8 * g4 + 4 * hh);
#pragma unroll
        for (int e = 0; e < 4; ++e) { const int reg = 4 * g4 + e, row = 8 * g4 + 4 * hh + e;
            AK[reg] = (r < row) ? be4[e] * rk4[e] * rk_own * KK[reg] * fexp(G4[e] - G) : 0.f;
            X[reg] = (row <= r) ? rq_own * rk4[e] * QKT[reg] * fexp(G - G4[e]) : 0.f; }
    }
    __builtin_amdgcn_sched_barrier(0);
    float Tc[32];
#pragma unroll
    for (int i = 0; i < 32; ++i) {
        float acc = (i == r) ? 1.f : 0.f;
#pragma unroll
        for (int j = 0; j < i; ++j) { const float a = __uint_as_float(__builtin_amdgcn_readlane(__float_as_uint(AK[(i & 3) + 4 * (i >> 3)]), j + 32 * ((i >> 2) & 1))); acc -= a * Tc[j]; }
        Tc[i] = acc;
        __builtin_amdgcn_sched_barrier(0);
    }
    __builtin_amdgcn_sched_barrier(0);
    float T2[32];
    { const float fv = rk_own * fexp(Glast - G);
#pragma unroll
      for (int i = 0; i < 32; ++i) { Tc[i] *= beta; T2[i] = Tc[i] * __uint_as_float(__builtin_amdgcn_readlane(__float_as_uint(fv), i)); } }
    bf16x8 aT1[2], aT2[2];
#pragma unroll
    for (int s = 0; s < 2; ++s) { v4u p1, p2;
#pragma unroll
        for (int q = 0; q < 4; ++q) { const int ja = 16 * s + 8 * ((2 * q) >> 2) + ((2 * q) & 3), jb = ja + 1;
            p1[q] = hh ? pkbf(Tc[ja + 4], Tc[jb + 4]) : pkbf(Tc[ja], Tc[jb]); p2[q] = hh ? pkbf(T2[ja + 4], T2[jb + 4]) : pkbf(T2[ja], T2[jb]); }
        aT1[s] = __builtin_bit_cast(bf16x8, p1); aT2[s] = __builtin_bit_cast(bf16x8, p2); }
    __builtin_amdgcn_sched_barrier(0);
    { f32x16 W;
#pragma unroll
      for (int i = 0; i < 16; ++i) W[i] = 0.f;
#pragma unroll
      for (int s = 0; s < 2; ++s) W = MFMA32(aT1[s], pack_step(X, s), W);
#pragma unroll
      for (int s = 0; s < 2; ++s) *(GAS bf16x8*)(rec + (24 + s) * 1024 + lane * 16) = pack_step(W, s); }
    __builtin_amdgcn_sched_barrier(0);
#pragma unroll
    for (int mt = 0; mt < 4; ++mt) { f32x16 Kt;
#pragma unroll
        for (int i = 0; i < 16; ++i) Kt[i] = 0.f;
#pragma unroll
        for (int s = 0; s < 2; ++s) { v4u p;
#pragma unroll
            for (int q = 0; q < 4; ++q) { const int ja = 16 * s + 8 * ((2 * q) >> 2) + 4 * hh + ((2 * q) & 3);
                const unsigned lo = *(const LAS unsigned short*)(KT_ + toff(ja, 32 * mt + r)), hi = *(const LAS unsigned short*)(KT_ + toff(ja + 1, 32 * mt + r)); p[q] = lo | (hi << 16); }
            Kt = MFMA32(aT2[s], __builtin_bit_cast(bf16x8, p), Kt); }
#pragma unroll
        for (int s = 0; s < 2; ++s) *(GAS bf16x8*)(rec + (16 + 2 * mt + s) * 1024 + lane * 16) = pack_step(Kt, s); }
    __builtin_amdgcn_sched_barrier(0);
    { const float eg = fexp(G), fk = -rk_own * eg, fq = rq_own * eg;
#pragma unroll
      for (int kt = 0; kt < 8; ++kt) { const int c0 = 16 * kt + 4 * hh;
          const v2u k0 = *(const LAS v2u*)(KT_ + toff(r, c0)), k1 = *(const LAS v2u*)(KT_ + toff(r, c0 + 8)), q0 = *(const LAS v2u*)(QT + toff(r, c0)), q1 = *(const LAS v2u*)(QT + toff(r, c0 + 8));
          v4u ko, qo;
          ko.x = pkbf(blo(k0.x) * fk, bhi(k0.x) * fk); ko.y = pkbf(blo(k0.y) * fk, bhi(k0.y) * fk); ko.z = pkbf(blo(k1.x) * fk, bhi(k1.x) * fk); ko.w = pkbf(blo(k1.y) * fk, bhi(k1.y) * fk);
          qo.x = pkbf(blo(q0.x) * fq, bhi(q0.x) * fq); qo.y = pkbf(blo(q0.y) * fq, bhi(q0.y) * fq); qo.z = pkbf(blo(q1.x) * fq, bhi(q1.x) * fq); qo.w = pkbf(blo(q1.y) * fq, bhi(q1.y) * fq);
          *(GAS v4u*)(rec + kt * 1024 + lane * 16) = ko; *(GAS v4u*)(rec + (8 + kt) * 1024 + lane * 16) = qo; } }
    if (lane == 0) *(GAS float*)(rec + 34 * 1024) = fexp(Glast);
    LDS_WAIT();
    { const int cb = 2048 + h * DH + 2 * lane;
      float w0[4], w1[4];
#pragma unroll
      for (int j = 0; j < 4; ++j) { w0[j] = A.in[3][j * 3072 + cb]; w1[j] = A.in[3][j * 3072 + cb + 1]; }
      unsigned raw[35]; unsigned voff = (unsigned)((lr0 - 3) * 16384 + cb * 2);
#pragma unroll
      for (int i = 0; i < 35; ++i) {
          if (i < 3 && n == 0) raw[i] = seg ? histr[i * 192 + 128 + lane] : 0u;
          else raw[i] = *(const GAS unsigned*)((const GAS unsigned char*)P + voff);
          voff += 16384u; asm volatile("" : "+v"(voff));
      }
      if (n == NCH - 1) {
#pragma unroll
          for (int i = 0; i < 3; ++i) histw[i * 192 + 128 + lane] = raw[32 + i]; }
#pragma unroll
      for (int t = 0; t < 32; ++t) {
          const float y0 = w0[0] * blo(raw[t]) + w0[1] * blo(raw[t + 1]) + w0[2] * blo(raw[t + 2]) + w0[3] * blo(raw[t + 3]);
          const float y1 = w1[0] * bhi(raw[t]) + w1[1] * bhi(raw[t + 1]) + w1[2] * bhi(raw[t + 2]) + w1[3] * bhi(raw[t + 3]);
          *(LAS unsigned*)(QT + toff(t, 2 * lane)) = pkbf(silu_f(y0), silu_f(y1));
      } }
    LDS_WAIT();
#pragma unroll
    for (int w = 0; w < 4; ++w) { v4u lo4, hi4;
#pragma unroll
        for (int q = 0; q < 8; ++q) { const unsigned a = *(const LAS unsigned short*)(QT + toff(crow(2 * q, hh), 32 * w + r)), bq = *(const LAS unsigned short*)(QT + toff(crow(2 * q + 1, hh), 32 * w + r));
            if (q < 4) lo4[q] = a | (bq << 16); else hi4[q - 4] = a | (bq << 16); }
        *(GAS v4u*)(rec + (26 + 2 * w) * 1024 + lane * 16) = lo4; *(GAS v4u*)(rec + (27 + 2 * w) * 1024 + lane * 16) = hi4; }
    LDS_WAIT();
}

constexpr int RING_SLOT = 36864, RING_SLOTS = 3, GRING_OFF = RING_SLOT * RING_SLOTS, GSLOT = 8192, OBUF_OFF = GRING_OFF + 3 * GSLOT, OBUF_BYTES = 32 * 128 * 2;
static_assert(OBUF_OFF + 2 * OBUF_BYTES <= MISC_OFF, "scan LDS map");
#define RAW_BAR() do { asm volatile("" ::: "memory"); __builtin_amdgcn_s_barrier(); asm volatile("" ::: "memory"); } while (0)

__device__ __forceinline__ float row16_sum(float v) {
    v += __uint_as_float(__builtin_amdgcn_update_dpp(0, __float_as_uint(v), 0xB1, 0xF, 0xF, true));
    v += __uint_as_float(__builtin_amdgcn_update_dpp(0, __float_as_uint(v), 0x4E, 0xF, 0xF, true));
    v += __uint_as_float(__builtin_amdgcn_update_dpp(0, __float_as_uint(v), 0x141, 0xF, 0xF, true));
    v += __uint_as_float(__builtin_amdgcn_update_dpp(0, __float_as_uint(v), 0x140, 0xF, 0xF, true));
    return v;
}
__device__ __forceinline__ void scan_post_chunk(Frame& F, const LAS unsigned char* ob, const LAS unsigned char* gs, int hw, int g0, int h, const float (&wn)[8], bf16* O, bool dry) {
    const int tsub = F.lane >> 4, dg = F.lane & 15;
#pragma unroll
    for (int ps = 0; ps < 2; ++ps) { const int tk = 8 * hw + 4 * ps + tsub;
        const v4u ow = *(const LAS v4u*)(ob + tk * 256 + dg * 16), gw = *(const LAS v4u*)(gs + tk * 256 + dg * 16);
        float a[8];
#pragma unroll
        for (int q = 0; q < 4; ++q) { a[2 * q] = blo(ow[q]); a[2 * q + 1] = bhi(ow[q]); }
        const float ss = row16_sum((a[0] * a[0] + a[1] * a[1]) + (a[2] * a[2] + a[3] * a[3]) + (a[4] * a[4] + a[5] * a[5]) + (a[6] * a[6] + a[7] * a[7]));
        const float rstd = rsqrtf(ss * (1.f / 128.f) + EPS);
        v4u o;
#pragma unroll
        for (int q = 0; q < 4; ++q) o[q] = pkbf(a[2 * q] * rstd * wn[2 * q] * blo(gw[q]), a[2 * q + 1] * rstd * wn[2 * q + 1] * bhi(gw[q]));
        bf16* Ow = dry ? (bf16*)(F.ws + 244 * MiB) + (size_t)((g0 + tk) & 4095) * D : O + (size_t)(g0 + tk) * D;
        *(GAS v4u*)(Ow + h * DH + 8 * dg) = o; }
}
template <int BR  >
__device__ __forceinline__ void scan_mfma(const Args& A, Frame& F, int seg, int b, int h, bool dry, int dflags = 0) {
    constexpr int NBLK = BR ? NBLK_B : NBLK_A, REC = NBLK * 1024, NLQ = NBLK / 4;
    const int bh = b * NH + h, lane = F.lane, wv = F.wave, r = lane & 31, hh = lane >> 5;
    const GAS unsigned char* recs = (const GAS unsigned char*)(F.ws + (BR ? WS_RECB : WS_RECA)) + (size_t)bh * NCH * REC;
    LAS unsigned char* ring = F.lds; LAS unsigned char* gring = F.lds + GRING_OFF; LAS unsigned char* obuf = F.lds + OBUF_OFF;
    if (wv < 4) {
        GAS float* ST = (GAS float*)(F.ws + WS_STATE) + (size_t)(BR * 16 + bh) * DH * DH + (size_t)wv * 4096;
        f32x16 S[4];
#pragma unroll
        for (int mt = 0; mt < 4; ++mt)
#pragma unroll
            for (int i = 0; i < 16; ++i) S[mt][i] = seg ? ST[(mt * 16 + i) * 64 + lane] : 0.f;
        __builtin_amdgcn_s_setprio(2);
        RAW_BAR();
#pragma unroll 1
        for (int n = 0; n < NCH; ++n) {
            const LAS unsigned char* sl = ring + (n % RING_SLOTS) * RING_SLOT + lane * 16; LAS unsigned char* ob = obuf + (n & 1) * OBUF_BYTES;
#define LDF(blk) (*(const LAS bf16x8*)(sl + (blk) * 1024))
            constexpr int PF = 6, NSTEP = BR ? 18 : 26;
            bf16x8 f[NSTEP], Sb[8];
            f32x16 o;
#pragma unroll
            for (int i = 0; i < 16; ++i) o[i] = 0.f;
            if constexpr (BR == 0) {
                const v4u v0 = *(const LAS v4u*)(sl + (26 + 2 * wv) * 1024), v1 = *(const LAS v4u*)(sl + (27 + 2 * wv) * 1024);
                const float gl = *(const LAS float*)(ring + (n % RING_SLOTS) * RING_SLOT + 34 * 1024);
#define BLKA(i) ((i) < 16 ? (i) : ((i) < 18 ? (i) + 8 : (i) - 2))
#pragma unroll
                for (int i = 0; i < PF; ++i) f[i] = LDF(BLKA(i));
                f32x16 R; bf16x8 Rb0, Rb1;
#pragma unroll
                for (int q = 0; q < 4; ++q) { R[2 * q] = blo(v0[q]); R[2 * q + 1] = bhi(v0[q]); R[8 + 2 * q] = blo(v1[q]); R[8 + 2 * q + 1] = bhi(v1[q]); }
#pragma unroll
                for (int i = 0; i < NSTEP; ++i) {
                    if (i + PF < NSTEP) f[i + PF] = LDF(BLKA(i + PF));
                    if (i < 8) { Sb[i] = pack_step(S[i >> 1], i & 1); R = MFMA32(f[i], Sb[i], R); }
                    else if (i < 16) { o = MFMA32(f[i], Sb[i - 8], o);
#pragma unroll
                        for (int e = 0; e < 8; ++e) S[(i - 8) >> 1][8 * ((i - 8) & 1) + e] *= gl; }
                    else if (i == 16) { Rb0 = pack_step(R, 0); Rb1 = pack_step(R, 1); o = MFMA32(f[i], Rb0, o); }
                    else if (i == 17) o = MFMA32(f[i], Rb1, o);
                    else S[(i - 18) >> 1] = MFMA32(f[i], ((i - 18) & 1) ? Rb1 : Rb0, S[(i - 18) >> 1]);
                    __builtin_amdgcn_sched_barrier(0);
                }
#undef BLKA
            } else {
                const bf16x8 Vb0 = *(const LAS bf16x8*)(sl + (18 + 2 * wv) * 1024), Vb1 = *(const LAS bf16x8*)(sl + (19 + 2 * wv) * 1024);
                const LAS float* gd = (const LAS float*)(ring + (n % RING_SLOTS) * RING_SLOT + 26 * 1024);
#define BLKB(i) ((i) < 8 ? (i) : ((i) < 10 ? (i) + 8 : (i) - 2))
#pragma unroll
                for (int i = 0; i < PF; ++i) f[i] = LDF(BLKB(i));
#pragma unroll
                for (int i = 0; i < NSTEP; ++i) {
                    if (i + PF < NSTEP) f[i + PF] = LDF(BLKB(i + PF));
                    if (i < 8) { Sb[i] = pack_step(S[i >> 1], i & 1); o = MFMA32(f[i], Sb[i], o);
                        const f32x4 ga = *(const LAS f32x4*)(gd + 32 * (i >> 1) + 16 * (i & 1) + 4 * hh), gb = *(const LAS f32x4*)(gd + 32 * (i >> 1) + 16 * (i & 1) + 8 + 4 * hh);
#pragma unroll
                        for (int e = 0; e < 4; ++e) { S[i >> 1][8 * (i & 1) + e] *= ga[e]; S[i >> 1][8 * (i & 1) + 4 + e] *= gb[e]; } }
                    else if (i == 8) o = MFMA32(f[i], Vb0, o);
                    else if (i == 9) o = MFMA32(f[i], Vb1, o);
                    else S[(i - 10) >> 1] = MFMA32(f[i], ((i - 10) & 1) ? Vb1 : Vb0, S[(i - 10) >> 1]);
                    __builtin_amdgcn_sched_barrier(0);
                }
#undef BLKB
            }
#undef LDF
#pragma unroll
            for (int i = 0; i < 16; ++i) *(LAS unsigned short*)(ob + crow(i, hh) * 256 + (32 * wv + r) * 2) = (unsigned short)pkbf(o[i], 0.f);
            LDS_WAIT(); RAW_BAR();
        }
        __builtin_amdgcn_s_setprio(0);
#pragma unroll
        for (int mt = 0; mt < 4; ++mt)
#pragma unroll
            for (int i = 0; i < 16; ++i) if (!dry) ST[(mt * 16 + i) * 64 + lane] = S[mt][i];
    } else {
        const int hw = wv - 4; float wn[8];
        { const float* onw = A.in[BR ? 8 : 6] + 8 * (lane & 15);
#pragma unroll
          for (int j = 0; j < 8; ++j) wn[j] = onw[j]; }
        bf16* O = (bf16*)(F.ws + (BR ? WS_OB : WS_OA)); const int gbase = b * T + seg * TSEG;
        const GAS unsigned char* gsrc = (const GAS unsigned char*)O + (size_t)gbase * (D * 2) + h * (DH * 2) + (size_t)(lane >> 4) * (D * 2) + (lane & 15) * 16;
        asm volatile("s_waitcnt vmcnt(0)" ::: "memory");
#define ISSUE_REC(nn) do { if (dflags & 2) break; const GAS unsigned char* rp_ = recs + (size_t)(nn) * REC + lane * 16; LAS unsigned char* dp_ = ring + ((nn) % RING_SLOTS) * RING_SLOT; \
        _Pragma("unroll") for (int k_ = 0; k_ < NLQ; ++k_) __builtin_amdgcn_global_load_lds((const GAS unsigned*)(rp_ + (hw + 4 * k_) * 1024), (LAS unsigned*)(dp_ + (hw + 4 * k_) * 1024), 16, 0, 0); } while (0)
#define ISSUE_GATE(cc) do { if (dflags & 2) break; const GAS unsigned char* gp_ = gsrc + (size_t)((cc) * NC + 8 * hw) * (D * 2); LAS unsigned char* dp_ = gring + ((cc) % 3) * GSLOT + 2 * hw * 1024; \
        __builtin_amdgcn_global_load_lds((const GAS unsigned*)gp_, (LAS unsigned*)dp_, 16, 0, 0); __builtin_amdgcn_global_load_lds((const GAS unsigned*)(gp_ + 4 * (D * 2)), (LAS unsigned*)(dp_ + 1024), 16, 0, 0); } while (0)
#define WAIT_OLDER() do { if constexpr (NLQ == 9) asm volatile("s_waitcnt vmcnt(11)" ::: "memory"); else asm volatile("s_waitcnt vmcnt(9)" ::: "memory"); } while (0)
        ISSUE_REC(0); ISSUE_REC(1); ISSUE_GATE(0);
        WAIT_OLDER();
        RAW_BAR();
#pragma unroll 1
        for (int n = 0; n < NCH; ++n) {
            if (n + 2 < NCH) ISSUE_REC(n + 2);
            if (n + 1 < NCH) ISSUE_GATE(n + 1);
            if (n >= 1 && !(dflags & 1)) scan_post_chunk(F, obuf + ((n - 1) & 1) * OBUF_BYTES, gring + ((n - 1) % 3) * GSLOT, hw, gbase + (n - 1) * NC, h, wn, O, dry);
            if (n + 2 < NCH) WAIT_OLDER(); else asm volatile("s_waitcnt vmcnt(0)" ::: "memory");
            LDS_WAIT(); RAW_BAR();
        }
        if (!(dflags & 1)) scan_post_chunk(F, obuf + ((NCH - 1) & 1) * OBUF_BYTES, gring + ((NCH - 1) % 3) * GSLOT, hw, gbase + (NCH - 1) * NC, h, wn, O, dry);
#undef ISSUE_REC
#undef ISSUE_GATE
#undef WAIT_OLDER
    }
    __syncthreads();
}

__device__ __forceinline__ void prepB_chunk(const Args& A, Frame& F, int seg, int b, int h, int n, LAS unsigned char* wl) {
    int lane_ = F.lane; asm volatile("" : "+v"(lane_));
    const int lane = lane_, r = lane & 31, hh = lane >> 5, bh = b * NH + h;
    const GAS bf16* P = (const GAS bf16*)(F.ws + WS_P);
    GAS unsigned char* rec = (GAS unsigned char*)(F.ws + WS_RECB) + (size_t)(bh * NCH + n) * REC_B;
    LAS unsigned char* QB = wl; LAS unsigned char* KB = wl + 8192; LAS float* gd = (LAS float*)(wl + 16384);
    const int lr0 = b * TSEG + n * NC;
    { const int c2 = h * DH + 2 * lane;
      const float la0 = A.in[7][c2], la1 = A.in[7][c2 + 1], lc0 = A.in[7][1024 + c2], lc1 = A.in[7][1024 + c2 + 1];
      const float lb0 = 1.f / (1.f + fexp(lc0 - la0)), lb1 = 1.f / (1.f + fexp(lc1 - la1));
      unsigned rf[32], rq[32]; unsigned voff = (unsigned)(lr0 * 16384 + (4096 + c2) * 2);
#pragma unroll
      for (int i = 0; i < 32; ++i) { rf[i] = *(const GAS unsigned*)((const GAS unsigned char*)P + voff); rq[i] = *(const GAS unsigned*)((const GAS unsigned char*)P + voff + 4096); voff += 16384u; asm volatile("" : "+v"(voff)); }
      float b0 = 0.f, b1 = 0.f;
#pragma unroll
      for (int t = 0; t < 32; ++t) {
          const float f0 = lb0 + (1.f - lb0) * sigmoid_f(blo(rf[t])), f1 = lb1 + (1.f - lb1) * sigmoid_f(bhi(rf[t]));
          b0 += __builtin_amdgcn_logf(f0) * 0.6931471805599453f; b1 += __builtin_amdgcn_logf(f1) * 0.6931471805599453f;
          *(LAS unsigned*)(QB + toff(t, 2 * lane)) = pkbf(silu_f(blo(rq[t])) * fexp(b0), silu_f(bhi(rq[t])) * fexp(b1));
          *(LAS unsigned*)(KB + toff(t, 2 * lane)) = pkbf((1.f - f0) * fexp(-b0), (1.f - f1) * fexp(-b1));
      }
      const float g0 = fexp(b0), g1 = fexp(b1);
      gd[2 * lane] = g0; gd[2 * lane + 1] = g1;
      *(GAS f32x2v*)(rec + 26 * 1024 + lane * 8) = (f32x2v){g0, g1}; }
    LDS_WAIT();
    __builtin_amdgcn_sched_barrier(0);
    { f32x16 X;
#pragma unroll
      for (int i = 0; i < 16; ++i) X[i] = 0.f;
#pragma unroll
      for (int kt = 0; kt < 8; ++kt) X = MFMA32(*(const LAS bf16x8*)(KB + toff(r, 16 * kt + 8 * hh)), *(const LAS bf16x8*)(QB + toff(r, 16 * kt + 8 * hh)), X);
#pragma unroll
      for (int i = 0; i < 16; ++i) X[i] = (crow(i, hh) <= r) ? X[i] : 0.f;
#pragma unroll
      for (int s = 0; s < 2; ++s) *(GAS bf16x8*)(rec + (16 + s) * 1024 + lane * 16) = pack_step(X, s); }
#pragma unroll
    for (int kt = 0; kt < 8; ++kt) { const int c0 = 16 * kt + 4 * hh;
        const v2u q0 = *(const LAS v2u*)(QB + toff(r, c0)), q1 = *(const LAS v2u*)(QB + toff(r, c0 + 8));
        v4u qo; qo.x = q0.x; qo.y = q0.y; qo.z = q1.x; qo.w = q1.y;
        *(GAS v4u*)(rec + kt * 1024 + lane * 16) = qo; }
#pragma unroll
    for (int mt = 0; mt < 4; ++mt) { const float gg = gd[32 * mt + r];
#pragma unroll
        for (int s = 0; s < 2; ++s) { v4u p;
#pragma unroll
            for (int q = 0; q < 4; ++q) { const int ja = 16 * s + 8 * ((2 * q) >> 2) + 4 * hh + ((2 * q) & 3);
                const unsigned short lo = *(const LAS unsigned short*)(KB + toff(ja, 32 * mt + r)), hi = *(const LAS unsigned short*)(KB + toff(ja + 1, 32 * mt + r));
                p[q] = pkbf(bf2f(lo) * gg, bf2f(hi) * gg); }
            *(GAS v4u*)(rec + (8 + 2 * mt + s) * 1024 + lane * 16) = p; } }
#pragma unroll
    for (int w = 0; w < 4; ++w) { v4u lo4, hi4; const GAS bf16* vp = P + (size_t)lr0 * 8192 + 5120 + h * DH + 32 * w + r;
#pragma unroll
        for (int q = 0; q < 8; ++q) { const unsigned a = vp[(size_t)crow(2 * q, hh) * 8192], bq = vp[(size_t)crow(2 * q + 1, hh) * 8192];
            if (q < 4) lo4[q] = a | (bq << 16); else hi4[q - 4] = a | (bq << 16); }
        *(GAS v4u*)(rec + (18 + 2 * w) * 1024 + lane * 16) = lo4; *(GAS v4u*)(rec + (19 + 2 * w) * 1024 + lane * 16) = hi4; }
    LDS_WAIT();
}

#define CE_D(a, b) do { const float hi_ = fmaxf(a, b), lo_ = fminf(a, b); a = hi_; b = lo_; } while (0)
#define CE_A(a, b) do { const float hi_ = fmaxf(a, b), lo_ = fminf(a, b); a = lo_; b = hi_; } while (0)
__device__ __forceinline__ void sort16_desc(float (&v)[64], const int base) {
#pragma unroll
    for (int k = 2; k <= 16; k <<= 1)
#pragma unroll
        for (int j = k >> 1; j > 0; j >>= 1)
#pragma unroll
            for (int i = 0; i < 16; ++i) { const int l = i ^ j; if (l > i) { if ((i & k) == 0) CE_D(v[base + i], v[base + l]); else CE_A(v[base + i], v[base + l]); } }
}
__device__ __forceinline__ void merge16_desc(float (&v)[64], const int base) {
#pragma unroll
    for (int j = 8; j > 0; j >>= 1)
#pragma unroll
        for (int i = 0; i < 16; ++i) { const int l = i ^ j; if (l > i) CE_D(v[base + i], v[base + l]); }
}
__device__ __forceinline__ void top16_of_64(float (&v)[64]) {
    sort16_desc(v, 0); sort16_desc(v, 16); sort16_desc(v, 32); sort16_desc(v, 48);
#pragma unroll
    for (int i = 0; i < 16; ++i) { v[i] = fmaxf(v[i], v[31 - i]); v[32 + i] = fmaxf(v[32 + i], v[63 - i]); }
    merge16_desc(v, 0); merge16_desc(v, 32);
#pragma unroll
    for (int i = 0; i < 16; ++i) v[i] = fmaxf(v[i], v[47 - i]);
    merge16_desc(v, 0);
}
__device__ __forceinline__ void f5_topk(const Args& A, Frame& F) {
    const GAS bf16* SKb = (const GAS bf16*)(F.ws + WS_SK); const GAS bf16* Q2 = (const GAS bf16*)(F.ws + WS_Q2);
    GAS int* IDX = (GAS int*)(F.ws + WS_IDX); GAS float* GATE = (GAS float*)(F.ws + WS_GATE);
    LAS unsigned char* skl = F.lds;
    LAS float* wl = (LAS float*)(F.lds + 69632 + F.wave * 8448);
    LAS unsigned char* tab = F.lds + 69632 + 8 * 8448;
    const int lane = F.lane, r = lane & 31, hh = lane >> 5;
    if (F.tid < 64) { int cid = 0, val = 0;
        for (int i = 0; i < 16; ++i) for (int j = 0; j < 16 / (i + 1); ++j) { if (cid == F.tid) val = (i << 4) | j; ++cid; }
        tab[F.tid] = (unsigned char)val; }
    for (int item = F.bid; item < 8 * 32; item += F.G) {
        const int h = item & 7, grp = item >> 3;
        __syncthreads();
        for (int e = F.tid; e < 2 * 128 * 16; e += NTHREADS) { const int p = e >> 11, k = (e >> 4) & 127, ch = e & 15;
            *(LAS v4u*)(skl + p * 34816 + k * 272 + ch * 16) = *(const GAS v4u*)(SKb + ((size_t)(p * 8 + h) * 128 + k) * 128 + ch * 8); }
        __syncthreads();
#pragma unroll 1
        for (int tl = 0; tl < 2; ++tl) {
            const int t = grp * 512 + (F.wave * 2 + tl) * 32 + r;
            float lst[2][16];
#pragma unroll
            for (int p = 0; p < 2; ++p) {
                f32x16 acc[4];
#pragma unroll
                for (int tile = 0; tile < 4; ++tile)
#pragma unroll
                    for (int i = 0; i < 16; ++i) acc[tile][i] = 0.f;
#pragma unroll
                for (int kt = 0; kt < 8; ++kt) {
                    const bf16x8 bq = *(const GAS bf16x8*)(Q2 + (size_t)t * 2048 + h * 256 + p * 128 + 16 * kt + 8 * hh);
#pragma unroll
                    for (int tile = 0; tile < 4; ++tile) acc[tile] = MFMA32(*(const LAS bf16x8*)(skl + p * 34816 + (32 * tile + r) * 272 + (16 * kt + 8 * hh) * 2), bq, acc[tile]);
                }
                float v[64];
#pragma unroll
                for (int tile = 0; tile < 4; ++tile)
#pragma unroll
                    for (int i = 0; i < 16; ++i) v[16 * tile + i] = __uint_as_float((__float_as_uint(acc[tile][i]) & ~127u) | (unsigned)(32 * tile + crow(i, hh)));
                top16_of_64(v);
#pragma unroll
                for (int i = 0; i < 16; ++i) v[16 + i] = __shfl_xor(v[i], 32);
#pragma unroll
                for (int i = 0; i < 16; ++i) v[i] = fmaxf(v[i], v[31 - i]);
                merge16_desc(v, 0);
#pragma unroll
                for (int i = 0; i < 16; ++i) lst[p][i] = v[i];
            }
            float c[64]; { int cid = 0;
#pragma unroll
                for (int i = 0; i < 16; ++i)
#pragma unroll
                    for (int j = 0; j < 16 / (i + 1); ++j) { c[cid] = __uint_as_float((__float_as_uint(lst[0][i] + lst[1][j]) & ~63u) | (unsigned)cid); ++cid; }
#pragma unroll
                for (int q = 50; q < 64; ++q) c[q] = -3.0e38f; }
            top16_of_64(c);
#pragma unroll
            for (int i = 0; i < 16; ++i) { wl[lane * 33 + i] = lst[0][i]; wl[lane * 33 + 16 + i] = lst[1][i]; }
            LDS_WAIT();
            float esum = 0.f, ex[16]; int id[16];
#pragma unroll
            for (int i = 0; i < 16; ++i) { ex[i] = __expf(c[i] - c[0]); esum += ex[i];
                const int ij = tab[__float_as_uint(c[i]) & 63u];
                const unsigned a = __float_as_uint(wl[lane * 33 + (ij >> 4)]), bq = __float_as_uint(wl[lane * 33 + 16 + (ij & 15)]);
                id[i] = (int)((a & 127u) * 128u + (bq & 127u)); }
            const float inv = 1.f / esum;
            if (hh == 0) {
#pragma unroll
                for (int q = 0; q < 4; ++q) *(GAS v4u*)(IDX + (size_t)t * 128 + h * 16 + 4 * q) = (v4u){(unsigned)id[4 * q], (unsigned)id[4 * q + 1], (unsigned)id[4 * q + 2], (unsigned)id[4 * q + 3]};
            } else {
#pragma unroll
                for (int q = 0; q < 4; ++q) *(GAS f32x4*)(GATE + (size_t)t * 128 + h * 16 + 4 * q) = (f32x4){ex[4 * q] * inv, ex[4 * q + 1] * inv, ex[4 * q + 2] * inv, ex[4 * q + 3] * inv};
            }
            LDS_WAIT();
        }
    }
}

constexpr int NPHASE = 16;
#ifndef PG8_ALIGN
#define PG8_ALIGN true
#endif
#ifndef PG8_SP2
#define PG8_SP2 true
#endif

__global__ void __launch_bounds__(NTHREADS, 2) mk_fwd(const Args args) {
    extern __shared__ __attribute__((aligned(16))) unsigned char lds[];
    Frame F;
    F.lds = (LAS unsigned char*)lds;
    F.tid = threadIdx.x; F.lane = F.tid & 63; F.wave = __builtin_amdgcn_readfirstlane(F.tid >> 6);
    F.G = gridDim.x; F.bid = blockIdx.x;
    F.ws = args.ws; F.out = args.out;
    for (int u = F.tid; u < (LDS_BYTES - MISC_OFF) / 4; u += NTHREADS) ((LAS unsigned*)(F.lds + MISC_OFF))[u] = 0u;
    __syncthreads();
    XcdBarrier bar; bar.bar = (unsigned*)(args.ws + WS_CTL) + CW_BAR; bar.x = 0; bar.st = nullptr;
    if (args.use_bar) bar = xcd_barrier_post((unsigned*)(args.ws + WS_CTL) + CW_BAR, (volatile LAS unsigned*)(F.lds + MISC_OFF) + 8);
    const int lo = args.ph_lo, hi = args.ph_hi;
#define IN(k) (lo <= (k) && (k) < hi)
#define REFRESH() do { int t_ = threadIdx.x; asm volatile("" : "+v"(t_)); F.tid = t_; F.lane = t_ & 63; F.wave = __builtin_amdgcn_readfirstlane(t_ >> 6); \
        unsigned char* w_ = args.ws; asm volatile("" : "+s"(w_)); F.ws = w_; float* o_ = args.out; asm volatile("" : "+s"(o_)); F.out = o_; \
        int b_ = blockIdx.x; asm volatile("" : "+s"(b_)); F.bid = b_; } while (0)
#ifdef REP_EXP
#define REPLOOP(k) for (int it_ = 0, nrep_ = (args.pad == (k) ? 2 : 1); it_ < nrep_; ++it_)
#define DRY(k) (args.pad == (k) && it_ == 0)
#else
#define REPLOOP(k)
#define DRY(k) false
#endif
#define SEAM(k) do { if (IN(k) && IN((k) + 1)) xcd_barrier(bar); } while (0)

    if (IN(0)) REPLOOP(100) {
        REFRESH();
        p0_weights(args, F, 0, F.bid, F.G);
        __syncthreads();
        norm_rows(args, F, 0, (bf16*)(F.ws + WS_XN), F.bid, F.G);
    }
    SEAM(0);
    if (IN(1)) REPLOOP(101) {
        REFRESH();
        if (F.bid < F.G - 32) {
            pg8::Gemm g{(const bf16*)(F.ws + WS_XN), (const bf16*)(F.ws + WS_WIN), MSEG, NPROJ, D}; pg8::StaticOrder S; S.init(MSEG, NPROJ, F.G - 32, F.bid);
            pg8::EpiP1 E{(bf16*)(F.ws + WS_P), (bf16*)F.out, (bf16*)(F.ws + WS_OA), (bf16*)(F.ws + WS_OB), (float*)(F.ws + WS_BA), 0};
            pg8::gemm_phase<pg8::EpiP1, pg8::StaticOrder, PG8_ALIGN, PG8_SP2>(F.lds, g, S, E);
        } else { p0_weights(args, F, 1, F.bid - (F.G - 32), 32); norm_rows(args, F, 1, (bf16*)(F.ws + WS_XN) + (size_t)MSEG * D, F.bid - (F.G - 32), 32); }
    }
    SEAM(1);
    for (int s = 0; s < NSEG; ++s) {
        if (IN(2 + 2 * s)) REPLOOP(102) {
            REFRESH();
            for (int id = F.bid * NWAVES + F.wave; id < 2 * 16 * NCH; id += F.G * NWAVES) {
                if (id < 16 * NCH) prepA_chunk(args, F, s, id >> 9, (id >> 6) & 7, id & 63, F.lds + F.wave * PW_BYTES);
                else prepB_chunk(args, F, s, (id >> 9) & 1, (id >> 6) & 7, id & 63, F.lds + F.wave * PW_BYTES); }
        }
        SEAM(2 + 2 * s);
#ifdef REP_EXP
        if (IN(3 + 2 * s)) for (int it_ = 0, nrep_ = ((args.pad >= 103 && args.pad <= 108) ? 2 : 1); it_ < nrep_; ++it_) {
            const bool skip_scan = (args.pad == 105 && it_ == 0), skip_gemm = ((args.pad == 104 || (args.pad >= 106 && args.pad <= 108)) && it_ == 0); const int dfl = (it_ == 0 && args.pad >= 106 && args.pad <= 108) ? args.pad - 105 : 0;
#undef DRY
#define DRY(k) (it_ == 0 && nrep_ == 2)
#else
        if (IN(3 + 2 * s)) { const bool skip_scan = false, skip_gemm = false; const int dfl = 0;
#endif
            REFRESH();
            if (F.bid < 32) { if (!skip_scan) { const int br = F.bid >> 4, b = (F.bid >> 3) & 1, h = F.bid & 7;
                if (br == 0) scan_mfma<0>(args, F, s, b, h, DRY(103), dfl); else scan_mfma<1>(args, F, s, b, h, DRY(103), dfl); } }
            else if (skip_gemm) {}
            else if (s + 1 < NSEG) {
                pg8::Gemm g{(const bf16*)(F.ws + WS_XN) + (size_t)((s + 1) & 1) * MSEG * D, (const bf16*)(F.ws + WS_WIN), MSEG, NPROJ, D}; pg8::StaticOrder S; S.init(MSEG, NPROJ, F.G - 32, F.bid - 32);
                pg8::EpiP1 E{(bf16*)(F.ws + WS_P), (bf16*)F.out, (bf16*)(F.ws + WS_OA), (bf16*)(F.ws + WS_OB), (float*)(F.ws + WS_BA), s + 1};
                pg8::gemm_phase<pg8::EpiP1, pg8::StaticOrder, PG8_ALIGN, PG8_SP2>(F.lds, g, S, E);
                if (s + 2 < NSEG) norm_rows(args, F, s + 2, (bf16*)(F.ws + WS_XN) + (size_t)(s & 1) * MSEG * D, F.bid - 32, F.G - 32);
            } else { p0_weights(args, F, 2, F.bid - 32, F.G - 32); convert_experts(args, F, F.bid - 32, F.G - 32); }
        }
        SEAM(3 + 2 * s);
    }
    if (IN(10)) REPLOOP(110) {
        REFRESH();
        static_assert(WS_OB == WS_OA + (size_t)M * D * 2 && WS_WB == WS_WA + (size_t)D * D * 2, "F1: [OA | OB] and [Wa_t | Wb_t] are contiguous");
        pg8::F1Order S; S.S.init(M, D, F.G, F.bid);
        pg8::Gemm g{(const bf16*)(F.ws + WS_OA), (const bf16*)(F.ws + WS_WA), 2 * M, 2 * D, D};
        pg8::EpiF1 E{pg8::EpiGate<0>{(const bf16*)F.out, 2048, nullptr, (float*)(F.ws + WS_YA), nullptr, D}, pg8::EpiGate<1>{(const bf16*)F.out + 1024, 2048, (const float*)(F.ws + WS_YA), nullptr, (bf16*)(F.ws + WS_MIX), D}};
        pg8::gemm_phase<pg8::EpiF1, pg8::F1Order, PG8_ALIGN, PG8_SP2>(F.lds, g, S, E);
    }
    SEAM(10);
    if (IN(11)) REPLOOP(111) {
        REFRESH();
        pg8::Gemm g{(const bf16*)(F.ws + WS_MIX), (const bf16*)(F.ws + WS_WO), M, D, D}; pg8::StaticOrder S; S.init(M, D, F.G, F.bid);
        pg8::EpiResNorm E{args.in[0], F.out, (bf16*)(F.ws + WS_H2), args.in[12], (float*)(F.ws + WS_SSP), D};
        pg8::gemm_phase<pg8::EpiResNorm, pg8::StaticOrder, false, PG8_SP2>(F.lds, g, S, E);
    }
    if (IN(11) && IN(13)) xcd_barrier(bar);
    if (IN(13)) REPLOOP(113) {
        REFRESH();
        pg8::Gemm g{(const bf16*)(F.ws + WS_H2), (const bf16*)(F.ws + WS_WPQ), M, 2048, D}; pg8::StaticOrder S; S.init(M, 2048, F.G, F.bid);
        pg8::EpiBf16RowScale E{(bf16*)(F.ws + WS_Q2), 2048, (const float*)(F.ws + WS_SSP), 1.f / D, EPS};
        pg8::gemm_phase<pg8::EpiBf16RowScale, pg8::StaticOrder, PG8_ALIGN, PG8_SP2>(F.lds, g, S, E);
    }
    SEAM(13);
    if (IN(14)) REPLOOP(114) { REFRESH(); f5_topk(args, F); }
    SEAM(14);
#ifdef REP_EXP
    if (IN(15)) for (int it_ = 0, nrep_ = ((args.pad >= 115 && args.pad <= 120) ? 2 : 1); it_ < nrep_; ++it_) { REFRESH(); f6_peer(args, F, it_ == 0 && nrep_ == 2, it_ == 0 && (args.pad == 116 || args.pad == 120), (it_ == 0 && (args.pad == 117 || args.pad == 120)) ? 0xffu : ((it_ == 0 && args.pad == 118) ? 1u : ((it_ == 0 && args.pad == 119) ? 3u : 0x3fffu))); }
#else
    if (IN(15)) { REFRESH(); f6_peer(args, F, false); }
#endif
#undef IN
#undef REFRESH
#undef SEAM
}

extern "C" void kernel_launch(void* const* d_in, const int* in_sizes, int n_in, void* d_out, int out_size, void* d_ws, size_t ws_size, hipStream_t stream) {
    static int grid = 0;
    if (grid == 0) {
        if (n_in != 18 || out_size != M * D || ws_size < WS_NEED) { fprintf(stderr, "kernel_launch: unexpected shapes (n_in %d out %d ws %zu)\n", n_in, out_size, ws_size); grid = -1; return; }
        int dev = 0, cus = 0, per_cu = 0;
        if (hipGetDevice(&dev) != hipSuccess || hipDeviceGetAttribute(&cus, hipDeviceAttributeMultiprocessorCount, dev) != hipSuccess) { grid = -1; return; }
        if (hipFuncSetAttribute((const void*)mk_fwd, hipFuncAttributeMaxDynamicSharedMemorySize, LDS_BYTES) != hipSuccess) { fprintf(stderr, "kernel_launch: hipFuncSetAttribute failed\n"); grid = -1; return; }
        if (hipOccupancyMaxActiveBlocksPerMultiprocessor(&per_cu, (const void*)mk_fwd, NTHREADS, LDS_BYTES) != hipSuccess || per_cu < 1) fprintf(stderr, "kernel_launch: occupancy query says %d\n", per_cu);
        (void)hipGetLastError();
        grid = cus;
    }
    if (grid < 0) return;
    (void)hipMemsetAsync((char*)d_ws + WS_CTL, 0, CTL_ZERO_BYTES, stream);
    Args a{};
    for (int i = 0; i < 18; ++i) a.in[i] = (const float*)d_in[i];
    a.out = (float*)d_out; a.ws = (unsigned char*)d_ws;
#ifdef REP_EXP
    a.pad = REP_EXP;
#endif
#if MK_ONE_LAUNCH
    a.ph_lo = 0; a.ph_hi = NPHASE; a.use_bar = 1;
    hipLaunchKernelGGL(mk_fwd, dim3(grid), dim3(NTHREADS), LDS_BYTES, stream, a);
#else
    for (int ph = 0; ph < NPHASE; ++ph) { a.ph_lo = ph; a.ph_hi = ph + 1; a.use_bar = 0; hipLaunchKernelGGL(mk_fwd, dim3(grid), dim3(NTHREADS), LDS_BYTES, stream, a); }
#endif
}
```

```cpp
#include <hip/hip_runtime.h>
#include <cstdio>
#include <cstdint>

#ifndef MK_ONE_LAUNCH
#define MK_ONE_LAUNCH 1
#endif

namespace pg8 {
#define PG8_LAS __attribute__((address_space(3)))
typedef unsigned short bf16_t;
typedef short bf16x8 __attribute__((ext_vector_type(8)));
typedef float f32x4 __attribute__((ext_vector_type(4)));
typedef unsigned u32x4 __attribute__((ext_vector_type(4)));
typedef unsigned u32x2 __attribute__((ext_vector_type(2)));
constexpr int BM = 256, BK = 64, HALF = 128, HTB = HALF * BK * 2, STAGE_BYTES = 8 * HTB, NXCD = 8, WGM = 8;

__host__ __device__ __forceinline__ int lds_byte(int r, int c) { const int st = (r >> 4) * 2 + (c >> 5), rr = r & 15, cc = c & 31, ob = rr * 64 + cc * 2; return st * 1024 + (ob ^ (((ob >> 9) & 1) << 5)); }
__host__ __device__ __forceinline__ void stage_rc(int b, int& R, int& C) { const int st = b / 1024, sb = b % 1024, swz = sb ^ (((sb >> 9) & 1) << 5); R = (st >> 1) * 16 + swz / 64; C = (st & 1) * 32 + (swz % 64) / 2; }
__host__ __device__ __forceinline__ int perm32(int rho) { const int n = rho >> 4, i = rho & 15; return 8 * (i >> 2) + 4 * n + (i & 3); }

struct Unit { int pm, pn; };
struct Gemm { const bf16_t* A; const bf16_t* Bt; int M, N, K; };

struct StaticOrder {
    int nM, nN, nwg, G, c;
    __host__ __device__ void init(int M, int N, int G_, int c_) { nM = M / BM; nN = N / BM; nwg = nM * nN; G = G_; c = c_; }
    __host__ __device__ bool next(int i, Unit& u) const {
        const long L = (long)i * G + c; if (L >= nwg) return false;
        int wgid = (int)L; { const int q = nwg / NXCD, r = nwg % NXCD, xcd = wgid % NXCD, off = wgid / NXCD; wgid = (xcd < r ? xcd * (q + 1) : r * (q + 1) + (xcd - r) * q) + off; }
        const int nig = WGM * nN, gid = wgid / nig, fm = gid * WGM, gsz = (nM - fm) < WGM ? (nM - fm) : WGM;
        u.pm = fm + ((wgid % nig) % gsz); u.pn = (wgid % nig) / gsz; return true;
    }
    __device__ __forceinline__ void a_ready(const Unit&) const {}
    __device__ __forceinline__ void done(const Unit&) const {}
};

__device__ __forceinline__ unsigned cvt_pk_bf16(float lo, float hi) { unsigned r; asm volatile("v_cvt_pk_bf16_f32 %0, %1, %2" : "=v"(r) : "v"(lo), "v"(hi)); return r; }
__device__ __forceinline__ float bflo(unsigned w) { return __uint_as_float(w << 16); }
__device__ __forceinline__ float bfhi(unsigned w) { return __uint_as_float(w & 0xffff0000u); }
__device__ __forceinline__ float sigm(float x) { return __builtin_amdgcn_rcpf(1.f + __builtin_amdgcn_exp2f(x * -1.4426950408889634f)); }

struct EpiBf16 {
    static constexpr bool PERM = true, AFTER_DRAIN = false;
    bf16_t* O; int ldc;
    __device__ __forceinline__ void operator()(const f32x4 (&acc)[2][2][4][2], const Unit& u, int wr, int wc, int fr, int fq) const {
        const int row0 = u.pm * BM + wr * 64 + fr, col0 = u.pn * BM + wc * 32 + 8 * fq;
#pragma unroll
        for (int ai = 0; ai < 2; ++ai)
#pragma unroll
            for (int m = 0; m < 4; ++m) { bf16_t* rowp = O + (size_t)(row0 + ai * HALF + m * 16) * ldc + col0;
#pragma unroll
                for (int bj = 0; bj < 2; ++bj) { const f32x4 v0 = acc[ai][bj][m][0], v1 = acc[ai][bj][m][1];
                    u32x4 w; w.x = cvt_pk_bf16(v0[0], v0[1]); w.y = cvt_pk_bf16(v0[2], v0[3]); w.z = cvt_pk_bf16(v1[0], v1[1]); w.w = cvt_pk_bf16(v1[2], v1[3]);
                    *(u32x4*)(rowp + bj * HALF) = w; } }
    }
};
struct EpiP1 {
    static constexpr bool PERM = true, AFTER_DRAIN = false;
    bf16_t* P; bf16_t* GAB; bf16_t* OA; bf16_t* OB; float* BA; int seg;
    __device__ __forceinline__ void operator()(const f32x4 (&acc)[2][2][4][2], const Unit& u, int wr, int wc, int fr, int fq) const {
        const int row0 = u.pm * BM + wr * 64 + fr; int colt = u.pn * BM;
        if (u.pn == 40) {
            if (wc == 0 && fq < 2) {
#pragma unroll
                for (int ai = 0; ai < 2; ++ai)
#pragma unroll
                    for (int m = 0; m < 4; ++m) { const int lr = row0 + ai * HALF + m * 16; const int gr = (lr >> 11) * 8192 + seg * 2048 + (lr & 2047);
                        *(f32x4*)(BA + (size_t)gr * 16 + 8 * fq) = acc[ai][0][m][0]; *(f32x4*)(BA + (size_t)gr * 16 + 8 * fq + 4) = acc[ai][0][m][1]; } }
            return; }
        const int act = (u.pn >= 12 && u.pn < 16) ? 1 : ((u.pn >= 28) ? 2 : 0);
        const bool glob = act != 0;
        bf16_t* base = P; int ldc = 8192;
        if (act == 1) { base = OA; ldc = 1024; colt -= 3072; } else if (u.pn >= 32) { base = GAB; ldc = 2048; colt -= 8192; } else if (act == 2) { base = OB; ldc = 1024; colt -= 7168; }
        const int col0 = colt + wc * 32 + 8 * fq;
#pragma unroll
        for (int ai = 0; ai < 2; ++ai)
#pragma unroll
            for (int m = 0; m < 4; ++m) { const int lr = row0 + ai * HALF + m * 16; const int gr = (lr >> 11) * 8192 + seg * 2048 + (lr & 2047);
                bf16_t* rowp = base + (size_t)(glob ? gr : lr) * ldc + col0;
#pragma unroll
                for (int bj = 0; bj < 2; ++bj) { f32x4 v0 = acc[ai][bj][m][0], v1 = acc[ai][bj][m][1];
                    if (act) {
#pragma unroll
                        for (int j = 0; j < 4; ++j) { const float s0 = sigm(v0[j]), s1 = sigm(v1[j]); v0[j] = act == 1 ? v0[j] * s0 : s0; v1[j] = act == 1 ? v1[j] * s1 : s1; } }
                    u32x4 w; w.x = cvt_pk_bf16(v0[0], v0[1]); w.y = cvt_pk_bf16(v0[2], v0[3]); w.z = cvt_pk_bf16(v1[0], v1[1]); w.w = cvt_pk_bf16(v1[2], v1[3]);
                    *(u32x4*)(rowp + bj * HALF) = w; } }
    }
};
template <int MODE> struct EpiGate {
    static constexpr bool PERM = true, AFTER_DRAIN = false;
    const bf16_t* gate; int gate_ld; const float* addin; float* outf; bf16_t* outb; int ldc;
    __device__ __forceinline__ void operator()(const f32x4 (&acc)[2][2][4][2], const Unit& u, int wr, int wc, int fr, int fq) const {
        const int row0 = u.pm * BM + wr * 64 + fr, col0 = u.pn * BM + wc * 32 + 8 * fq;
#pragma unroll
        for (int ai = 0; ai < 2; ++ai)
#pragma unroll
            for (int m = 0; m < 4; ++m) { const size_t r = (size_t)(row0 + ai * HALF + m * 16);
#pragma unroll
                for (int bj = 0; bj < 2; ++bj) { const int c = col0 + bj * HALF;
                    const u32x4 gw = *(const u32x4*)(gate + r * gate_ld + c);
                    f32x4 v0 = acc[ai][bj][m][0], v1 = acc[ai][bj][m][1];
                    v0[0] *= bflo(gw.x); v0[1] *= bfhi(gw.x); v0[2] *= bflo(gw.y); v0[3] *= bfhi(gw.y); v1[0] *= bflo(gw.z); v1[1] *= bfhi(gw.z); v1[2] *= bflo(gw.w); v1[3] *= bfhi(gw.w);
                    if (MODE == 1) { const u32x4 aw = *(const u32x4*)((const bf16_t*)addin + r * ldc + c);
                        v0[0] += bflo(aw.x); v0[1] += bfhi(aw.x); v0[2] += bflo(aw.y); v0[3] += bfhi(aw.y); v1[0] += bflo(aw.z); v1[1] += bfhi(aw.z); v1[2] += bflo(aw.w); v1[3] += bfhi(aw.w); }
                    u32x4 w; w.x = cvt_pk_bf16(v0[0], v0[1]); w.y = cvt_pk_bf16(v0[2], v0[3]); w.z = cvt_pk_bf16(v1[0], v1[1]); w.w = cvt_pk_bf16(v1[2], v1[3]);
                    *(u32x4*)((MODE == 0 ? (bf16_t*)outf : outb) + r * ldc + c) = w; } }
    }
};
struct EpiRes {
    static constexpr bool PERM = false, AFTER_DRAIN = false;
    const float* base; float* out; int ldc;
    __device__ __forceinline__ void operator()(const f32x4 (&acc)[2][2][4][2], const Unit& u, int wr, int wc, int fr, int fq) const {
        const int row0 = u.pm * BM + wr * 64 + fr, col0 = u.pn * BM + wc * 32 + 4 * fq;
#pragma unroll
        for (int ai = 0; ai < 2; ++ai)
#pragma unroll
            for (int m = 0; m < 4; ++m) { const size_t r = (size_t)(row0 + ai * HALF + m * 16);
#pragma unroll
                for (int bj = 0; bj < 2; ++bj)
#pragma unroll
                    for (int n = 0; n < 2; ++n) { const int c = col0 + bj * HALF + n * 16;
                        *(f32x4*)(out + r * ldc + c) = *(const f32x4*)(base + r * ldc + c) + acc[ai][bj][m][n]; } }
    }
};

struct F1Order {
    StaticOrder S;
    __device__ __forceinline__ bool next(int i, Unit& u) const { if (i > 1 || !S.next(0, u)) return false; if (i == 1) { u.pm += 64; u.pn += 4; } return true; }
    __device__ __forceinline__ void a_ready(const Unit&) const {}
    __device__ __forceinline__ void done(const Unit&) const {}
};
struct EpiF1 {
    static constexpr bool PERM = true, AFTER_DRAIN = false;
    EpiGate<0> e0; EpiGate<1> e1;
    __device__ __forceinline__ void operator()(const f32x4 (&acc)[2][2][4][2], const Unit& u, int wr, int wc, int fr, int fq) const {
        if (u.pm < 64) e0(acc, u, wr, wc, fr, fq); else { Unit v; v.pm = u.pm - 64; v.pn = u.pn - 4; e1(acc, v, wr, wc, fr, fq); }
    }
};
struct EpiResNorm {
    static constexpr bool PERM = true, AFTER_DRAIN = true;
    const float* base; float* out; bf16_t* xb; const float* g2; float* ssp; int ldc;
    __device__ __forceinline__ void fused(f32x4 (&acc)[2][2][4][2], const Unit& u, int wr, int wc, int fr, int fq, PG8_LAS unsigned char* lds, int wid, int lane) const {
        PG8_LAS float* part = (PG8_LAS float*)lds;
        const int row0 = u.pm * BM + wr * 64 + fr, col0 = u.pn * BM + wc * 32 + 8 * fq;
        f32x4 gv[2][2];
#pragma unroll
        for (int bj = 0; bj < 2; ++bj)
#pragma unroll
            for (int n = 0; n < 2; ++n) gv[bj][n] = *(const f32x4*)(g2 + col0 + bj * HALF + 4 * n);
#pragma unroll
        for (int ai = 0; ai < 2; ++ai)
#pragma unroll
            for (int m = 0; m < 4; ++m) { const size_t r = (size_t)(row0 + ai * HALF + m * 16); float ss = 0.f;
#pragma unroll
                for (int bj = 0; bj < 2; ++bj) { const int c = col0 + bj * HALF;
                    const f32x4 xa = *(const f32x4*)(base + r * ldc + c) + acc[ai][bj][m][0], xc = *(const f32x4*)(base + r * ldc + c + 4) + acc[ai][bj][m][1];
                    ss += (xa[0] * xa[0] + xa[1] * xa[1]) + (xa[2] * xa[2] + xa[3] * xa[3]) + (xc[0] * xc[0] + xc[1] * xc[1]) + (xc[2] * xc[2] + xc[3] * xc[3]);
                    u32x4 xw; xw.x = cvt_pk_bf16(xa[0], xa[1]); xw.y = cvt_pk_bf16(xa[2], xa[3]); xw.z = cvt_pk_bf16(xc[0], xc[1]); xw.w = cvt_pk_bf16(xc[2], xc[3]);
                    *(u32x4*)((bf16_t*)out + r * (2 * ldc) + ldc + c) = xw;
                    const f32x4 ha = xa * gv[bj][0], hc = xc * gv[bj][1];
                    u32x4 hw; hw.x = cvt_pk_bf16(ha[0], ha[1]); hw.y = cvt_pk_bf16(ha[2], ha[3]); hw.z = cvt_pk_bf16(hc[0], hc[1]); hw.w = cvt_pk_bf16(hc[2], hc[3]);
                    *(u32x4*)(xb + r * ldc + c) = hw; }
                ss += __shfl_xor(ss, 16); ss += __shfl_xor(ss, 32);
                if (fq == 0) part[wc * 256 + ai * HALF + wr * 64 + m * 16 + fr] = ss; }
        asm volatile("s_waitcnt lgkmcnt(0)" ::: "memory"); __builtin_amdgcn_s_barrier(); asm volatile("" ::: "memory");
        const int t = wid * 64 + lane;
        if (t < 256) ssp[(size_t)(u.pm * BM + t) * 4 + u.pn] = (part[t] + part[256 + t]) + (part[512 + t] + part[768 + t]);
    }
};
struct EpiBf16RowScale {
    static constexpr bool PERM = true, AFTER_DRAIN = false;
    bf16_t* O; int ldc; const float* ssp; float inv_n, eps;
    __device__ __forceinline__ void operator()(const f32x4 (&acc)[2][2][4][2], const Unit& u, int wr, int wc, int fr, int fq) const {
        const int row0 = u.pm * BM + wr * 64 + fr, col0 = u.pn * BM + wc * 32 + 8 * fq;
#pragma unroll
        for (int ai = 0; ai < 2; ++ai)
#pragma unroll
            for (int m = 0; m < 4; ++m) { const size_t r = (size_t)(row0 + ai * HALF + m * 16); const f32x4 sp = *(const f32x4*)(ssp + r * 4);
                const float rs = __builtin_amdgcn_rsqf(((sp[0] + sp[1]) + (sp[2] + sp[3])) * inv_n + eps);
                bf16_t* rowp = O + r * ldc + col0;
#pragma unroll
                for (int bj = 0; bj < 2; ++bj) { const f32x4 v0 = acc[ai][bj][m][0] * rs, v1 = acc[ai][bj][m][1] * rs;
                    u32x4 w; w.x = cvt_pk_bf16(v0[0], v0[1]); w.y = cvt_pk_bf16(v0[2], v0[3]); w.z = cvt_pk_bf16(v1[0], v1[1]); w.w = cvt_pk_bf16(v1[2], v1[3]);
                    *(u32x4*)(rowp + bj * HALF) = w; } }
    }
};

template <class Epi, class Sched, bool ALIGN_EPI = false, bool SP2 = false>
__device__ __forceinline__ void gemm_phase(PG8_LAS unsigned char* lds, const Gemm g, const Sched& S, const Epi& E) {
    const int tid = threadIdx.x, wid = __builtin_amdgcn_readfirstlane(tid >> 6), lane = tid & 63, wr = wid >> 2, wc = wid & 3, fr = lane & 15, fq = lane >> 4;
    const int K = g.K, nt = K / BK;
    unsigned voffA[2], voffB[2];
#pragma unroll
    for (int i = 0; i < 2; ++i) { int R, C; stage_rc(tid * 16 + i * 8192, R, C); const int Rb = Epi::PERM ? ((R & ~31) + perm32(R & 31)) : R;
        voffA[i] = (unsigned)(R * K + C) * 2u; voffB[i] = (unsigned)(Rb * K + C) * 2u; }
    const size_t kstep = (size_t)(BK * 2);
    const size_t hstep = (size_t)HALF * K * 2;
    const size_t tstep = 2 * hstep;
    const unsigned ldsw = (unsigned)wid * 1024u;
    const int aoff = lds_byte(wr * 64 + fr, fq * 8), boff = lds_byte(wc * 32 + fr, fq * 8);
#define PG8_SA(b, h) (((b) * 2 + (h)) * HTB)
#define PG8_SB(b, h) ((4 + (b) * 2 + (h)) * HTB)
#define PG8_STAGE(bufoff, gbase, voff) do { _Pragma("unroll") for (int _i = 0; _i < 2; ++_i) \
        __builtin_amdgcn_global_load_lds((const unsigned*)((const char*)(gbase) + (voff)[_i]), (PG8_LAS unsigned*)(lds + (bufoff) + ldsw + _i * 8192), 16, 0, 0); } while (0)
#define PG8_LDA(dst, b, h) do { _Pragma("unroll") for (int m = 0; m < 4; ++m) _Pragma("unroll") for (int k = 0; k < 2; ++k) dst[m][k] = *(const PG8_LAS bf16x8*)(lds + PG8_SA(b, h) + aoff + m * 2048 + k * 1024); } while (0)
#define PG8_LDB(dst, b, h) do { _Pragma("unroll") for (int n = 0; n < 2; ++n) _Pragma("unroll") for (int k = 0; k < 2; ++k) dst[n][k] = *(const PG8_LAS bf16x8*)(lds + PG8_SB(b, h) + boff + n * 2048 + k * 1024); } while (0)
#define PG8_MMA(ai, bj, At, Bt) do { __builtin_amdgcn_s_setprio(1); _Pragma("unroll") for (int m = 0; m < 4; ++m) _Pragma("unroll") for (int n = 0; n < 2; ++n) _Pragma("unroll") for (int k = 0; k < 2; ++k) \
        acc[ai][bj][m][n] = __builtin_amdgcn_mfma_f32_16x16x32_bf16(Bt[n][k], At[m][k], acc[ai][bj][m][n], 0, 0, 0); __builtin_amdgcn_s_setprio(0); } while (0)
#define PG8_WAIT_V(n) asm volatile("s_waitcnt vmcnt(" #n ")" ::: "memory")
#define PG8_WAIT_L(n) asm volatile("s_waitcnt lgkmcnt(" #n ")" ::: "memory")
#define PG8_BAR __builtin_amdgcn_s_barrier()
#define PG8_SCHED __builtin_amdgcn_sched_barrier(0)
    Unit cur, nxt; int ui = 0;
    if (!S.next(0, cur)) return;
    f32x4 acc[2][2][4][2];
#pragma unroll
    for (int a = 0; a < 2; ++a)
#pragma unroll
        for (int b = 0; b < 2; ++b)
#pragma unroll
            for (int m = 0; m < 4; ++m)
#pragma unroll
                for (int n = 0; n < 2; ++n) acc[a][b][m][n] = (f32x4){0.f, 0.f, 0.f, 0.f};
    bf16x8 At[4][2], B0[2][2], B1[2][2];
    const char* cA = (const char*)g.A + (size_t)cur.pm * tstep; const char* cB = (const char*)g.Bt + (size_t)cur.pn * tstep;
    S.a_ready(cur);
    if constexpr (SP2) {
        PG8_STAGE(PG8_SB(0, 0), cB, voffB); PG8_STAGE(PG8_SB(0, 1), cB + hstep, voffB); PG8_STAGE(PG8_SA(0, 0), cA, voffA); PG8_STAGE(PG8_SA(0, 1), cA + hstep, voffA);
        if (wr == 1) PG8_BAR;
        PG8_WAIT_V(2); PG8_BAR;
        PG8_STAGE(PG8_SB(1, 0), cB + kstep, voffB); PG8_STAGE(PG8_SA(1, 0), cA + kstep, voffA); PG8_STAGE(PG8_SB(1, 1), cB + hstep + kstep, voffB);
        PG8_WAIT_V(6); PG8_BAR;
    } else {
        PG8_STAGE(PG8_SB(0, 0), cB, voffB); PG8_STAGE(PG8_SA(0, 0), cA, voffA); PG8_STAGE(PG8_SB(0, 1), cB + hstep, voffB); PG8_STAGE(PG8_SA(0, 1), cA + hstep, voffA);
        if (wr == 1) PG8_BAR;
        PG8_WAIT_V(4); PG8_BAR;
        PG8_STAGE(PG8_SB(1, 0), cB + kstep, voffB); PG8_STAGE(PG8_SA(1, 0), cA + kstep, voffA); PG8_STAGE(PG8_SB(1, 1), cB + hstep + kstep, voffB);
        PG8_WAIT_V(6); PG8_BAR;
    }
    for (;;) {
        const bool has_next = S.next(ui + 1, nxt);
        const char* nA = has_next ? (const char*)g.A + (size_t)nxt.pm * tstep : cA; const char* nB = has_next ? (const char*)g.Bt + (size_t)nxt.pn * tstep : cB;
        for (int t = 0; t < nt; t += 2) {
            const bool last = (t == nt - 2);
            const char* a1 = cA + (size_t)(t + 1) * kstep;
            const char* a2 = last ? nA : cA + (size_t)(t + 2) * kstep; const char* b2 = last ? nB : cB + (size_t)(t + 2) * kstep;
            const char* a3 = a2 + kstep; const char* b3 = b2 + kstep;
            if (last && has_next) S.a_ready(nxt);
            if constexpr (SP2) {
            PG8_LDB(B0, 0, 0); PG8_LDB(B1, 0, 1); PG8_SCHED; PG8_LDA(At, 0, 0); PG8_STAGE(PG8_SA(1, 1), a1 + hstep, voffA);
            PG8_WAIT_V(8); PG8_WAIT_L(0); PG8_BAR; PG8_MMA(0, 0, At, B0); PG8_MMA(0, 1, At, B1); PG8_BAR; PG8_SCHED;
            PG8_LDA(At, 0, 1); PG8_STAGE(PG8_SB(0, 0), b2, voffB); PG8_STAGE(PG8_SB(0, 1), b2 + hstep, voffB); PG8_STAGE(PG8_SA(0, 0), a2, voffA);
            PG8_WAIT_V(8); PG8_WAIT_L(0); PG8_BAR; PG8_MMA(1, 0, At, B0); PG8_MMA(1, 1, At, B1); PG8_BAR; PG8_SCHED;
            PG8_LDB(B0, 1, 0); PG8_LDB(B1, 1, 1); PG8_SCHED; PG8_LDA(At, 1, 0); PG8_STAGE(PG8_SA(0, 1), a2 + hstep, voffA);
            PG8_WAIT_V(8); PG8_WAIT_L(0); PG8_BAR; PG8_MMA(0, 0, At, B0); PG8_MMA(0, 1, At, B1); PG8_BAR; PG8_SCHED;
            PG8_LDA(At, 1, 1); PG8_STAGE(PG8_SB(1, 0), b3, voffB); PG8_STAGE(PG8_SB(1, 1), b3 + hstep, voffB); PG8_STAGE(PG8_SA(1, 0), a3, voffA);
            PG8_WAIT_V(8); PG8_WAIT_L(0); PG8_BAR; PG8_MMA(1, 0, At, B0); PG8_MMA(1, 1, At, B1); PG8_BAR; PG8_SCHED;
            } else {
            PG8_LDB(B0, 0, 0); PG8_SCHED; PG8_LDA(At, 0, 0); PG8_STAGE(PG8_SA(1, 1), a1 + hstep, voffA);
            PG8_WAIT_L(8); PG8_BAR; PG8_WAIT_L(0); PG8_MMA(0, 0, At, B0); PG8_BAR; PG8_SCHED;
            PG8_LDB(B1, 0, 1); PG8_STAGE(PG8_SB(0, 0), b2, voffB);
            PG8_BAR; PG8_WAIT_L(0); PG8_MMA(0, 1, At, B1); PG8_BAR;
            PG8_LDA(At, 0, 1); PG8_STAGE(PG8_SA(0, 0), a2, voffA);
            PG8_BAR; PG8_WAIT_L(0); PG8_MMA(1, 0, At, B0); PG8_BAR; PG8_SCHED;
            PG8_STAGE(PG8_SB(0, 1), b2 + hstep, voffB);
            PG8_WAIT_V(6); PG8_BAR; PG8_MMA(1, 1, At, B1); PG8_BAR;
            PG8_LDB(B0, 1, 0); PG8_SCHED; PG8_LDA(At, 1, 0); PG8_STAGE(PG8_SA(0, 1), a2 + hstep, voffA);
            PG8_WAIT_L(8); PG8_BAR; PG8_WAIT_L(0); PG8_MMA(0, 0, At, B0); PG8_BAR; PG8_SCHED;
            PG8_LDB(B1, 1, 1); PG8_STAGE(PG8_SB(1, 0), b3, voffB);
            PG8_BAR; PG8_WAIT_L(0); PG8_MMA(0, 1, At, B1); PG8_BAR;
            PG8_LDA(At, 1, 1); PG8_STAGE(PG8_SA(1, 0), a3, voffA);
            PG8_BAR; PG8_WAIT_L(0); PG8_MMA(1, 0, At, B0); PG8_BAR; PG8_SCHED;
            PG8_STAGE(PG8_SB(1, 1), b3 + hstep, voffB);
            PG8_WAIT_V(6); PG8_BAR; PG8_MMA(1, 1, At, B1); PG8_BAR;
            }
        }
        if constexpr (ALIGN_EPI) { if (wr == 0) PG8_BAR; }
        if constexpr (!Epi::AFTER_DRAIN) { E(acc, cur, wr, wc, fr, fq); S.done(cur); }
        if (!has_next) break;
#pragma unroll
        for (int a = 0; a < 2; ++a)
#pragma unroll
            for (int b = 0; b < 2; ++b)
#pragma unroll
                for (int m = 0; m < 4; ++m)
#pragma unroll
                    for (int n = 0; n < 2; ++n) acc[a][b][m][n] = (f32x4){0.f, 0.f, 0.f, 0.f};
        cur = nxt; cA = nA; cB = nB; ++ui;
        if constexpr (ALIGN_EPI) { if (wr == 1) PG8_BAR; }
    }
    PG8_WAIT_V(0);
    if constexpr (!ALIGN_EPI) { if (wr == 0) PG8_BAR; }
    PG8_BAR;
    if constexpr (Epi::AFTER_DRAIN) { E.fused(acc, cur, wr, wc, fr, fq, lds, wid, lane); S.done(cur); }
#undef PG8_SA
#undef PG8_SB
#undef PG8_STAGE
#undef PG8_LDA
#undef PG8_LDB
#undef PG8_MMA
#undef PG8_WAIT_V
#undef PG8_WAIT_L
#undef PG8_BAR
#undef PG8_SCHED
}
}

constexpr int NWAVES = 8, NTHREADS = 512;
constexpr int BATCH = 2, T = 8192, D = 1024, M = BATCH * T;
constexpr int NSEG = 4, TSEG = T / NSEG, MSEG = BATCH * TSEG;
constexpr int IN_W = 11280, NPROJ = 10496;
constexpr int NH = 8, DH = 128;
constexpr int NEXP = 16384, PH = 8, PTOPK = 16, NKEYS = 128;
constexpr float EPS = 1e-6f;

constexpr size_t MiB = 1u << 20;
constexpr size_t WS_CTL = 0, CTL_ZERO_BYTES = 1 * MiB;
constexpr size_t WS_BA = 1 * MiB, WS_STATE = 2 * MiB, WS_HIST = 4 * MiB, WS_SK = 4 * MiB + 512 * 1024;
constexpr size_t WS_WA = 5 * MiB, WS_WB = 7 * MiB, WS_WO = 9 * MiB, WS_WPQ = 11 * MiB, WS_WIN = 15 * MiB + 512 * 1024;
constexpr size_t WS_XN = 36 * MiB, WS_P = 52 * MiB, WS_OA = 116 * MiB, WS_OB = 148 * MiB, WS_PREP = 180 * MiB;
constexpr size_t WS_YA = 180 * MiB, WS_MIX = 16 * MiB, WS_H2 = 180 * MiB, WS_Q2 = 116 * MiB, WS_IDX = 212 * MiB, WS_GATE = 220 * MiB;
constexpr size_t WS_EU = 52 * MiB, WS_EV = 68 * MiB;
constexpr size_t WS_SSP = 228 * MiB;
constexpr size_t WS_NEED = 244 * MiB;
constexpr int CW_BAR = 4096;

constexpr int LDS_BYTES = 163840;
constexpr int MISC_OFF = LDS_BYTES - 256;

#define GAS __attribute__((address_space(1)))
#define LAS __attribute__((address_space(3)))
typedef unsigned short bf16;
typedef unsigned v4u __attribute__((ext_vector_type(4)));
typedef unsigned v2u __attribute__((ext_vector_type(2)));
typedef float f32x4 __attribute__((ext_vector_type(4)));
typedef GAS unsigned gu32;
#define RLX_AGENT __ATOMIC_RELAXED, __HIP_MEMORY_SCOPE_AGENT
#define LDS_WAIT() asm volatile("s_waitcnt lgkmcnt(0)" ::: "memory")
#define VM_WAIT() asm volatile("s_waitcnt vmcnt(0)" ::: "memory")
__device__ __forceinline__ unsigned f2bf(float f) { unsigned u = __builtin_bit_cast(unsigned, f); return (u + 0x7fffu + ((u >> 16) & 1u)) >> 16; }
__device__ __forceinline__ unsigned pk2(float lo, float hi) { return f2bf(lo) | (f2bf(hi) << 16); }
__device__ __forceinline__ float bf2f(unsigned short b) { return __uint_as_float(((unsigned)b) << 16); }
__device__ __forceinline__ float blo(unsigned w) { return __uint_as_float(w << 16); }
__device__ __forceinline__ float bhi(unsigned w) { return __uint_as_float(w & 0xffff0000u); }
__device__ __forceinline__ float fexp(float x) { return __builtin_amdgcn_exp2f(x * 1.4426950408889634f); }
__device__ __forceinline__ float sigmoid_f(float x) { return __builtin_amdgcn_rcpf(1.f + fexp(-x)); }
__device__ __forceinline__ float silu_f(float x) { return x * __builtin_amdgcn_rcpf(1.f + fexp(-x)); }
__device__ __forceinline__ float softplus_f(float x) { return fmaxf(x, 0.f) + log1pf(__expf(-fabsf(x))); }
typedef __bf16 bf2_t __attribute__((ext_vector_type(2)));
__device__ __forceinline__ float dot2bf(unsigned a, unsigned b, float c) { return __builtin_amdgcn_fdot2_f32_bf16(__builtin_bit_cast(bf2_t, a), __builtin_bit_cast(bf2_t, b), c, false); }
__device__ __forceinline__ float wave_sum(float v) {
#pragma unroll
    for (int o = 1; o < 64; o <<= 1) v += __shfl_xor(v, o);
    return v;
}

#define XB_TMO      128
#define XB_XCNT(j)  (256  + 64 * (j))
#define XB_XSUB(j)  (1280 + 64 * (j))
#define XB_XGEN(j)  (2304 + 64 * (j))
#define XB_TOP      3328
#define XB_TOPGEN   3392
#define XCD_BAR_WORDS 3456
#define XB_SPIN_CAP (1u << 18)

__device__ __forceinline__ unsigned xb_ld(unsigned* p)              { return __hip_atomic_load(p, __ATOMIC_RELAXED, __HIP_MEMORY_SCOPE_AGENT); }
__device__ __forceinline__ unsigned xb_add(unsigned* p, unsigned v) { return __hip_atomic_fetch_add(p, v, __ATOMIC_RELAXED, __HIP_MEMORY_SCOPE_AGENT); }
__device__ __forceinline__ unsigned xb_xcc_id() { return (unsigned)__builtin_amdgcn_s_getreg((3 << 11) | 20) & 0xFu; }
#define XB_SPIN(cond, bar) do { unsigned _sp = 0; while (cond) { __builtin_amdgcn_s_sleep(1); \
    if ((++_sp & 255u) == 0u) { if (xb_ld(&(bar)[XB_TMO])) break; if (_sp > XB_SPIN_CAP) { atomicAdd(&(bar)[XB_TMO], 1u); break; } } } } while (0)

struct XcdBarrier {
    unsigned* bar; unsigned x;
    volatile LAS unsigned* st;
};

__device__ __forceinline__ XcdBarrier xcd_barrier_post(unsigned* bar, volatile LAS unsigned* st) {
    XcdBarrier b; b.bar = bar; b.x = xb_xcc_id(); b.st = st;
    if (threadIdx.x == 0) (void)xb_add(&bar[XB_XCNT(b.x)], 1u);
    return b;
}
__device__ __forceinline__ void xcd_barrier_complete(unsigned* bar, unsigned x, unsigned& nloc, unsigned& nx) {
    const unsigned G = gridDim.x * gridDim.y * gridDim.z;
    unsigned sum, cnt, mine, sp = 0u;
    for (;;) {
        sum = 0u; cnt = 0u; mine = 0u;
#pragma unroll
        for (unsigned j = 0; j < 16; ++j) { const unsigned c = xb_ld(&bar[XB_XCNT(j)]); sum += c; cnt += (c > 0u) ? 1u : 0u; mine = (j == x) ? c : mine; }
        if (sum == G) break;
        __builtin_amdgcn_s_sleep(1);
        if ((++sp & 255u) == 0u) { if (xb_ld(&bar[XB_TMO])) break; if (sp > XB_SPIN_CAP) { atomicAdd(&bar[XB_TMO], 1u); break; } }
    }
    nloc = mine > 0u ? mine : 1u; nx = cnt > 0u ? cnt : 1u;
}

__device__ __forceinline__ void xcd_barrier(const XcdBarrier& b) {
    asm volatile("s_waitcnt vmcnt(0)" ::: "memory");
    __syncthreads();
    if (threadIdx.x == 0) {
        unsigned* bar = b.bar;
        __builtin_amdgcn_s_waitcnt(0);
        unsigned nloc = b.st[0], nx = b.st[1];
        if (nloc == 0u) { xcd_barrier_complete(bar, b.x, nloc, nx); b.st[0] = nloc; b.st[1] = nx; }
        const unsigned old = xb_add(&bar[XB_XSUB(b.x)], 1u);
        const unsigned gen = old / nloc;
        if (old + 1u == (gen + 1u) * nloc) {
            __builtin_amdgcn_fence(__ATOMIC_RELEASE, "agent");
            asm volatile("s_waitcnt vmcnt(0)" ::: "memory");
            const unsigned og = xb_add(&bar[XB_TOP], 1u);
            const unsigned tg = og / nx;
            if (og + 1u == (tg + 1u) * nx) xb_add(&bar[XB_TOPGEN], 1u);
            else XB_SPIN(xb_ld(&bar[XB_TOPGEN]) == tg, bar);
            __builtin_amdgcn_fence(__ATOMIC_ACQUIRE, "agent");
            xb_add(&bar[XB_XGEN(b.x)], 1u);
            asm volatile("s_waitcnt vmcnt(0)" ::: "memory");
        } else {
            XB_SPIN(xb_ld(&bar[XB_XGEN(b.x)]) == gen, bar);
            __builtin_amdgcn_fence(__ATOMIC_ACQUIRE, "agent");
            asm volatile("s_waitcnt vmcnt(0)" ::: "memory");
        }
    }
    __syncthreads();
}

struct Args { const float* in[18]; float* out; unsigned char* ws; int ph_lo, ph_hi, use_bar, pad; };
struct Frame {
    LAS unsigned char* lds;
    int tid, lane, wave, G, bid;
    unsigned char* ws;
    float* out;
};

__device__ __forceinline__ void p0_transpose_item(const float* W, int ldw, int K, bf16* WT, int n_dst0, int n_src0, int k0, LAS float* scr, int lane) {
#pragma unroll 8
    for (int i = 0; i < 32; ++i) { const int kk = 2 * i + (lane >> 5); scr[kk * 33 + (lane & 31)] = W[(size_t)(k0 + kk) * ldw + n_src0 + (lane & 31)]; }
    LDS_WAIT(); asm volatile("" ::: "memory");
    const int c = lane & 7;
#pragma unroll
    for (int j = 0; j < 4; ++j) { const int n = (lane >> 3) + 8 * j; const LAS float* s = scr + (8 * c) * 33 + n;
        v4u o; o.x = pk2(s[0 * 33], s[1 * 33]); o.y = pk2(s[2 * 33], s[3 * 33]); o.z = pk2(s[4 * 33], s[5 * 33]); o.w = pk2(s[6 * 33], s[7 * 33]);
        *(GAS v4u*)(WT + (size_t)(n_dst0 + n) * K + k0 + 8 * c) = o; }
    LDS_WAIT(); asm volatile("" ::: "memory");
}
__device__ __forceinline__ void p0_weights(const Args& A, Frame& F, int part, int wg_rank, int wg_count) {
    LAS float* scr = (LAS float*)(F.lds + F.wave * 16384);
    const int gw = wg_rank * NWAVES + F.wave, NGW = wg_count * NWAVES;
    constexpr int NPJ = 10240, I_IN = (D / 64) * (NPJ / 32), I_SQ = (D / 64) * (D / 32), I_PQ = (D / 64) * (2048 / 32);
    constexpr int NITEMS = I_IN + 3 * I_SQ + I_PQ;
    bf16* Win_t = (bf16*)(F.ws + WS_WIN); bf16* Wa_t = (bf16*)(F.ws + WS_WA); bf16* Wb_t = (bf16*)(F.ws + WS_WB); bf16* Wo_t = (bf16*)(F.ws + WS_WO); bf16* Wpq_t = (bf16*)(F.ws + WS_WPQ);
    const int it_lo = part == 0 ? 0 : (part == 1 ? I_IN : I_IN + 2 * I_SQ), it_hi = part == 0 ? I_IN : (part == 1 ? I_IN + 2 * I_SQ : NITEMS);
    for (int it = it_lo + gw; it < it_hi; it += NGW) {
        int r = it;
        if (r < I_IN) { const int nblk = NPJ / 32, kb = r / nblk, nb = r % nblk, n0 = 32 * nb; p0_transpose_item(A.in[2], IN_W, D, Win_t, n0, n0 + (n0 >= 3072 ? 16 : 0), 64 * kb, scr, F.lane); continue; } r -= I_IN;
        if (r < I_SQ) { const int kb = r / 32, nb = r % 32; p0_transpose_item(A.in[9], D, D, Wa_t, 32 * nb, 32 * nb, 64 * kb, scr, F.lane); continue; } r -= I_SQ;
        if (r < I_SQ) { const int kb = r / 32, nb = r % 32; p0_transpose_item(A.in[10], D, D, Wb_t, 32 * nb, 32 * nb, 64 * kb, scr, F.lane); continue; } r -= I_SQ;
        if (r < I_SQ) { const int kb = r / 32, nb = r % 32; p0_transpose_item(A.in[11], D, D, Wo_t, 32 * nb, 32 * nb, 64 * kb, scr, F.lane); continue; } r -= I_SQ;
        { const int kb = r / 64, nb = r % 64; p0_transpose_item(A.in[13], 2048, D, Wpq_t, 32 * nb, 32 * nb, 64 * kb, scr, F.lane); }
    }
    if (part == 0) {
    for (int i = wg_rank * NTHREADS + F.tid; i < 256 * (D / 2); i += wg_count * NTHREADS) { const int n = i / (D / 2), k2 = (i % (D / 2)) * 2;
        const unsigned v = n < 16 ? pk2(A.in[2][(size_t)k2 * IN_W + 3072 + n], A.in[2][(size_t)(k2 + 1) * IN_W + 3072 + n]) : 0u;
        *(unsigned*)(Win_t + (size_t)(NPJ + n) * D + k2) = v; }
    return; }
    if (part == 2) return;
    bf16* SKb = (bf16*)(F.ws + WS_SK);
    for (int i = wg_rank * NTHREADS + F.tid; i < 2 * 8 * 128 * 128 / 8; i += wg_count * NTHREADS) {
        const f32x4 a = ((const f32x4*)A.in[14])[2 * i], b = ((const f32x4*)A.in[14])[2 * i + 1];
        v4u o; o.x = pk2(a[0], a[1]); o.y = pk2(a[2], a[3]); o.z = pk2(b[0], b[1]); o.w = pk2(b[2], b[3]);
        ((v4u*)SKb)[i] = o; }
}
__device__ __forceinline__ void norm_rows(const Args& A, Frame& F, int seg, bf16* XN, int wg_rank, int wg_count) {
    f32x4 gn[4];
#pragma unroll
    for (int j = 0; j < 4; ++j) gn[j] = ((const f32x4*)A.in[1])[F.lane + 64 * j];
    for (int lr = wg_rank * NWAVES + F.wave; lr < MSEG; lr += wg_count * NWAVES) {
        const int g = (lr >> 11) * T + seg * TSEG + (lr & 2047);
        const f32x4* xr = (const f32x4*)(A.in[0] + (size_t)g * D) + F.lane;
        f32x4 v[4]; float ss = 0.f;
#pragma unroll
        for (int j = 0; j < 4; ++j) { v[j] = xr[64 * j]; ss += (v[j][0] * v[j][0] + v[j][1] * v[j][1]) + (v[j][2] * v[j][2] + v[j][3] * v[j][3]); }
        const float rstd = rsqrtf(wave_sum(ss) * (1.f / D) + EPS);
        unsigned long long* o8 = (unsigned long long*)(XN + (size_t)lr * D) + F.lane;
#pragma unroll
        for (int j = 0; j < 4; ++j) { v[j] = v[j] * rstd * gn[j]; o8[64 * j] = (unsigned long long)pk2(v[j][0], v[j][1]) | ((unsigned long long)pk2(v[j][2], v[j][3]) << 32); }
    }
}

constexpr int SC_RAW = 0, SC_GATE = 49152, SC_BA = 65536, SC_QK = 66048, SC_SS = 68096, SC_RED = 68224, SC_RED2 = 72320, SC_OBUF = 76416;
__device__ __forceinline__ void scan_post64(const Args& A, Frame& F, int g0, int h, const float* onorm, int act  , bf16* O) {
    LAS float* obuf = (LAS float*)(F.lds + SC_OBUF); const LAS bf16* gate = (const LAS bf16*)(F.lds + SC_GATE);
    const float w0 = onorm[F.lane], w1 = onorm[F.lane + 64];
    for (int tt = F.wave * 8; tt < F.wave * 8 + 8; ++tt) {
        const float o0 = obuf[tt * 128 + F.lane], o1 = obuf[tt * 128 + 64 + F.lane];
        const float rstd = rsqrtf(wave_sum(o0 * o0 + o1 * o1) * (1.f / 128.f) + EPS);
        const float g0v = bf2f(gate[tt * 128 + F.lane]), g1v = bf2f(gate[tt * 128 + 64 + F.lane]);
        const float a0 = g0v, a1 = g1v;
        bf16* orow = O + (size_t)(g0 + tt) * D + h * DH;
        orow[F.lane] = (bf16)f2bf(o0 * rstd * w0 * a0); orow[F.lane + 64] = (bf16)f2bf(o1 * rstd * w1 * a1);
    }
}
__device__ __forceinline__ void scanA_naive(const Args& A, Frame& F, int seg, int b, int h) {
    const int c = F.tid & 127, qd = F.tid >> 7, bh = b * NH + h;
    const bf16* P = (const bf16*)(F.ws + WS_P); const float* BA = (const float*)(F.ws + WS_BA);
    float* ST = (float*)(F.ws + WS_STATE) + (size_t)bh * DH * DH; float* HI = (float*)(F.ws + WS_HIST) + (size_t)bh * 9 * 128;
    LAS bf16* raw = (LAS bf16*)(F.lds + SC_RAW); LAS bf16* gateL = (LAS bf16*)(F.lds + SC_GATE); LAS float* baL = (LAS float*)(F.lds + SC_BA);
    LAS float* qk = (LAS float*)(F.lds + SC_QK); LAS float* ssL = (LAS float*)(F.lds + SC_SS); LAS float* red = (LAS float*)(F.lds + SC_RED); LAS float* red2 = (LAS float*)(F.lds + SC_RED2);
    LAS float* obuf = (LAS float*)(F.lds + SC_OBUF);
    float S[32];
#pragma unroll
    for (int i = 0; i < 32; ++i) S[i] = seg ? ST[(qd * 32 + i) * DH + c] : 0.f;
    float hq[3], hk[3], hv[3];
#pragma unroll
    for (int j = 0; j < 3; ++j) { hq[j] = seg ? HI[j * 128 + c] : 0.f; hk[j] = seg ? HI[(3 + j) * 128 + c] : 0.f; hv[j] = seg ? HI[(6 + j) * 128 + c] : 0.f; }
    float wq[4], wk[4], wv[4];
#pragma unroll
    for (int j = 0; j < 4; ++j) { wq[j] = A.in[3][j * 3072 + h * DH + c]; wk[j] = A.in[3][j * 3072 + 1024 + h * DH + c]; wv[j] = A.in[3][j * 3072 + 2048 + h * DH + c]; }
    const float nega = -__expf(A.in[4][h]), dtb = A.in[5][h];
#pragma unroll 1
    for (int t0 = 0; t0 < TSEG; t0 += 64) {
        const int lr0 = b * TSEG + t0, g0 = b * T + seg * TSEG + t0;
        __syncthreads();
#pragma unroll 2
        for (int e = F.tid; e < 64 * 64; e += NTHREADS) { const int row = e >> 6, sgc = e & 63, sg = sgc >> 4, ch = sgc & 15;
            const v4u val = *(const v4u*)(P + (size_t)(lr0 + row) * 8192 + sg * 1024 + h * DH + ch * 8);
            if (sg < 3) *(LAS v4u*)(raw + row * 384 + sg * 128 + ch * 8) = val; else *(LAS v4u*)(gateL + row * 128 + ch * 8) = val; }
        if (F.tid < 64) { const float be = BA[(size_t)(g0 + F.tid) * 16 + h], al = BA[(size_t)(g0 + F.tid) * 16 + 8 + h];
            baL[F.tid * 2] = sigmoid_f(be); baL[F.tid * 2 + 1] = __expf(nega * softplus_f(al + dtb)); }
        __syncthreads();
#pragma unroll 1
        for (int t = 0; t < 64; ++t) {
            const int par = t & 1;
            const float xq = bf2f(raw[t * 384 + c]), xk = bf2f(raw[t * 384 + 128 + c]), xv = bf2f(raw[t * 384 + 256 + c]);
            const float qc = silu_f(wq[0] * hq[0] + wq[1] * hq[1] + wq[2] * hq[2] + wq[3] * xq);
            const float kc = silu_f(wk[0] * hk[0] + wk[1] * hk[1] + wk[2] * hk[2] + wk[3] * xk);
            const float vc = silu_f(wv[0] * hv[0] + wv[1] * hv[1] + wv[2] * hv[2] + wv[3] * xv);
            hq[0] = hq[1]; hq[1] = hq[2]; hq[2] = xq; hk[0] = hk[1]; hk[1] = hk[2]; hk[2] = xk; hv[0] = hv[1]; hv[1] = hv[2]; hv[2] = xv;
            const float sq = wave_sum(qc * qc), sk = wave_sum(kc * kc);
            if (qd == 0) { qk[par * 256 + c] = qc; qk[par * 256 + 128 + c] = kc; }
            if (F.lane == 0) { ssL[par * 16 + F.wave * 2] = sq; ssL[par * 16 + F.wave * 2 + 1] = sk; }
            __syncthreads();
            const float rq = rsqrtf(ssL[par * 16 + 0] + ssL[par * 16 + 2] + EPS) * 0.08838834764831845f, rk = rsqrtf(ssL[par * 16 + 1] + ssL[par * 16 + 3] + EPS);
            float skp = 0.f;
#pragma unroll
            for (int i4 = 0; i4 < 8; ++i4) { const f32x4 kk = *(const LAS f32x4*)(qk + par * 256 + 128 + qd * 32 + 4 * i4);
                skp += (kk[0] * S[4 * i4] + kk[1] * S[4 * i4 + 1]) + (kk[2] * S[4 * i4 + 2] + kk[3] * S[4 * i4 + 3]); if ((i4 & 3) == 3) asm volatile("" ::: "memory"); }
            skp *= rk;
            red[par * 512 + qd * 128 + c] = skp;
            __syncthreads();
            const float Sk = (red[par * 512 + c] + red[par * 512 + 128 + c]) + (red[par * 512 + 256 + c] + red[par * 512 + 384 + c]);
            const float beta = baL[t * 2], a = baL[t * 2 + 1];
            const float dl = beta * (vc - a * Sk) * rk;
            float op = 0.f;
#pragma unroll
            for (int i4 = 0; i4 < 8; ++i4) { const f32x4 kk = *(const LAS f32x4*)(qk + par * 256 + 128 + qd * 32 + 4 * i4), qq = *(const LAS f32x4*)(qk + par * 256 + qd * 32 + 4 * i4);
#pragma unroll
                for (int j = 0; j < 4; ++j) { S[4 * i4 + j] = a * S[4 * i4 + j] + kk[j] * dl; op += qq[j] * S[4 * i4 + j]; }
                if ((i4 & 1) == 1) asm volatile("" ::: "memory"); }
            red2[par * 512 + qd * 128 + c] = op * rq;
            __syncthreads();
            if (qd == 0) obuf[t * 128 + c] = (red2[par * 512 + c] + red2[par * 512 + 128 + c]) + (red2[par * 512 + 256 + c] + red2[par * 512 + 384 + c]);
        }
        __syncthreads();
        scan_post64(A, F, g0, h, A.in[6], 0, (bf16*)(F.ws + WS_OA));
    }
#pragma unroll
    for (int i = 0; i < 32; ++i) ST[(qd * 32 + i) * DH + c] = S[i];
    if (qd == 0) {
#pragma unroll
        for (int j = 0; j < 3; ++j) { HI[j * 128 + c] = hq[j]; HI[(3 + j) * 128 + c] = hk[j]; HI[(6 + j) * 128 + c] = hv[j]; } }
}
__device__ __forceinline__ void scanB_naive(const Args& A, Frame& F, int seg, int b, int h) {
    const int c = F.tid & 127, qd = F.tid >> 7, bh = b * NH + h;
    const bf16* P = (const bf16*)(F.ws + WS_P);
    float* ST = (float*)(F.ws + WS_STATE) + (size_t)(16 + bh) * DH * DH;
    LAS bf16* raw = (LAS bf16*)(F.lds + SC_RAW); LAS bf16* gateL = (LAS bf16*)(F.lds + SC_GATE);
    LAS float* fq = (LAS float*)(F.lds + SC_QK); LAS float* red = (LAS float*)(F.lds + SC_RED); LAS float* obuf = (LAS float*)(F.lds + SC_OBUF);
    float S[32];
#pragma unroll
    for (int i = 0; i < 32; ++i) S[i] = seg ? ST[(qd * 32 + i) * DH + c] : 0.f;
    const float l0 = A.in[7][h * DH + c], l1 = A.in[7][1024 + h * DH + c];
    const float lb = 1.f / (1.f + __expf(l1 - l0));
#pragma unroll 1
    for (int t0 = 0; t0 < TSEG; t0 += 64) {
        const int lr0 = b * TSEG + t0, g0 = b * T + seg * TSEG + t0;
        __syncthreads();
#pragma unroll 2
        for (int e = F.tid; e < 64 * 64; e += NTHREADS) { const int row = e >> 6, sgc = e & 63, sg = sgc >> 4, ch = sgc & 15;
            const v4u val = *(const v4u*)(P + (size_t)(lr0 + row) * 8192 + (4 + sg) * 1024 + h * DH + ch * 8);
            if (sg < 3) *(LAS v4u*)(raw + row * 384 + sg * 128 + ch * 8) = val; else *(LAS v4u*)(gateL + row * 128 + ch * 8) = val; }
        __syncthreads();
#pragma unroll 1
        for (int t = 0; t < 64; ++t) {
            const int par = t & 1;
            const float f = lb + (1.f - lb) * sigmoid_f(bf2f(raw[t * 384 + c])), v = bf2f(raw[t * 384 + 128 + c]), q = silu_f(bf2f(raw[t * 384 + 256 + c]));
            if (qd == 0) { fq[par * 256 + c] = f; fq[par * 256 + 128 + c] = q; }
            __syncthreads();
            float op = 0.f;
#pragma unroll
            for (int i4 = 0; i4 < 8; ++i4) { const f32x4 ff = *(const LAS f32x4*)(fq + par * 256 + qd * 32 + 4 * i4), qq = *(const LAS f32x4*)(fq + par * 256 + 128 + qd * 32 + 4 * i4);
#pragma unroll
                for (int j = 0; j < 4; ++j) { S[4 * i4 + j] = ff[j] * S[4 * i4 + j] + (1.f - ff[j]) * v; op += qq[j] * S[4 * i4 + j]; }
                if ((i4 & 1) == 1) asm volatile("" ::: "memory"); }
            red[par * 512 + qd * 128 + c] = op;
            __syncthreads();
            if (qd == 0) obuf[t * 128 + c] = (red[par * 512 + c] + red[par * 512 + 128 + c]) + (red[par * 512 + 256 + c] + red[par * 512 + 384 + c]);
        }
        __syncthreads();
        scan_post64(A, F, g0, h, A.in[8], 1, (bf16*)(F.ws + WS_OB));
    }
#pragma unroll
    for (int i = 0; i < 32; ++i) ST[(qd * 32 + i) * DH + c] = S[i];
}

__device__ __forceinline__ void f3_h2(const Args& A, Frame& F) {
    bf16* H2 = (bf16*)(F.ws + WS_H2);
    f32x4 gn[4];
#pragma unroll
    for (int j = 0; j < 4; ++j) gn[j] = ((const f32x4*)A.in[12])[F.lane + 64 * j];
    for (int r = F.bid * NWAVES + F.wave; r < M; r += F.G * NWAVES) {
        const f32x4* xr = (const f32x4*)(F.out + (size_t)r * D) + F.lane;
        f32x4 v[4]; float ss = 0.f;
#pragma unroll
        for (int j = 0; j < 4; ++j) { v[j] = xr[64 * j]; ss += (v[j][0] * v[j][0] + v[j][1] * v[j][1]) + (v[j][2] * v[j][2] + v[j][3] * v[j][3]); }
        const float rstd = rsqrtf(wave_sum(ss) * (1.f / D) + EPS);
        unsigned long long* o8 = (unsigned long long*)(H2 + (size_t)r * D) + F.lane;
#pragma unroll
        for (int j = 0; j < 4; ++j) { v[j] = v[j] * rstd * gn[j]; o8[64 * j] = (unsigned long long)pk2(v[j][0], v[j][1]) | ((unsigned long long)pk2(v[j][2], v[j][3]) << 32); }
    }
}

constexpr float EU_SCALE = 128.f, EV_SCALE = 16.f;
__device__ __forceinline__ unsigned pk4_fp8(const f32x4 v, float s) { int w = 0; w = __builtin_amdgcn_cvt_pk_fp8_f32(v[0] * s, v[1] * s, w, false); w = __builtin_amdgcn_cvt_pk_fp8_f32(v[2] * s, v[3] * s, w, true); return (unsigned)w; }
__device__ __forceinline__ void convert_experts(const Args& A, Frame& F, int wg_rank, int wg_count) {
    v4u* EU = (v4u*)(F.ws + WS_EU); v4u* EV = (v4u*)(F.ws + WS_EV);
    for (int i = wg_rank * NTHREADS + F.tid; i < NEXP * D / 16; i += wg_count * NTHREADS) {
        const f32x4* pu = (const f32x4*)A.in[15] + 4 * (size_t)i; const f32x4* pv = (const f32x4*)A.in[16] + 4 * (size_t)i;
        const f32x4 a0 = pu[0], a1 = pu[1], a2 = pu[2], a3 = pu[3], c0 = pv[0], c1 = pv[1], c2 = pv[2], c3 = pv[3];
        EU[i] = (v4u){pk4_fp8(a0, EU_SCALE), pk4_fp8(a1, EU_SCALE), pk4_fp8(a2, EU_SCALE), pk4_fp8(a3, EU_SCALE)};
        EV[i] = (v4u){pk4_fp8(c0, EV_SCALE), pk4_fp8(c1, EV_SCALE), pk4_fp8(c2, EV_SCALE), pk4_fp8(c3, EV_SCALE)}; }
}

__device__ __forceinline__ void wave_argmax(float& v, int& i) {
#pragma unroll
    for (int o = 32; o >= 1; o >>= 1) { const float ov = __shfl_xor(v, o); const int oi = __shfl_xor(i, o); if (ov > v || (ov == v && oi < i)) { v = ov; i = oi; } }
}
__device__ __forceinline__ void f5_topk_naive(const Args& A, Frame& F) {
    const bf16* SKb = (const bf16*)(F.ws + WS_SK); const bf16* Q2 = (const bf16*)(F.ws + WS_Q2);
    int* IDX = (int*)(F.ws + WS_IDX); float* GATE = (float*)(F.ws + WS_GATE);
    LAS unsigned char* skl = F.lds; LAS unsigned char* qa = F.lds + 69632 + F.wave * 512;
    for (int item = F.bid; item < 8 * 32; item += F.G) {
        const int h = item & 7, grp = item >> 3;
        __syncthreads();
        for (int e = F.tid; e < 2 * 128 * 16; e += NTHREADS) { const int p = e >> 11, k = (e >> 4) & 127, ch = e & 15;
            *(LAS v4u*)(skl + p * 34816 + k * 272 + ch * 16) = *(const v4u*)(SKb + ((size_t)(p * 8 + h) * 128 + k) * 128 + ch * 8); }
        __syncthreads();
        for (int tt = 0; tt < 64; ++tt) {
            const int t = grp * 512 + F.wave * 64 + tt;
            if (F.lane < 32) *(LAS v4u*)(qa + F.lane * 16) = *(const v4u*)(Q2 + (size_t)t * 2048 + h * 256 + F.lane * 8);
            LDS_WAIT();
            float tops[2]; int topi[2];
#pragma unroll
            for (int p = 0; p < 2; ++p) {
                float s0 = 0.f, s1 = 0.f;
#pragma unroll 4
                for (int ch = 0; ch < 16; ++ch) {
                    const v4u qv = *(const LAS v4u*)(qa + p * 256 + ch * 16);
                    const v4u k0 = *(const LAS v4u*)(skl + p * 34816 + F.lane * 272 + ch * 16), k1 = *(const LAS v4u*)(skl + p * 34816 + (F.lane + 64) * 272 + ch * 16);
#pragma unroll
                    for (int j = 0; j < 4; ++j) { const float ql = blo(qv[j]), qh = bhi(qv[j]); s0 += ql * blo(k0[j]) + qh * bhi(k0[j]); s1 += ql * blo(k1[j]) + qh * bhi(k1[j]); }
                }
                float tv = -3.0e38f; int ti = 0;
                for (int r = 0; r < 16; ++r) {
                    float bv = s0 >= s1 ? s0 : s1; int bi = s0 >= s1 ? F.lane : F.lane + 64;
                    wave_argmax(bv, bi);
                    if (F.lane == r) { tv = bv; ti = bi; }
                    if (bi == F.lane) s0 = -3.0e38f; if (bi == F.lane + 64) s1 = -3.0e38f;
                }
                tops[p] = tv; topi[p] = ti;
            }
            float cand[4];
#pragma unroll
            for (int e = 0; e < 4; ++e) cand[e] = __shfl(tops[0], F.lane >> 2) + __shfl(tops[1], (F.lane & 3) * 4 + e);
            float bs = -3.0e38f; int bc = 0;
            for (int r = 0; r < 16; ++r) {
                float bv = cand[0]; int bi = F.lane * 4;
#pragma unroll
                for (int e = 1; e < 4; ++e) if (cand[e] > bv) { bv = cand[e]; bi = F.lane * 4 + e; }
                wave_argmax(bv, bi);
                if (F.lane == r) { bs = bv; bc = bi; }
#pragma unroll
                for (int e = 0; e < 4; ++e) if (bi == F.lane * 4 + e) cand[e] = -3.0e38f;
            }
            const float mx = __shfl(bs, 0);
            const float ex = F.lane < 16 ? __expf(bs - mx) : 0.f;
            const float sum = wave_sum(ex);
            const int i0 = __shfl(topi[0], bc >> 4), i1 = __shfl(topi[1], bc & 15);
            if (F.lane < 16) { IDX[(size_t)t * 128 + h * 16 + F.lane] = i0 * 128 + i1; GATE[(size_t)t * 128 + h * 16 + F.lane] = ex / sum; }
        }
    }
}

__device__ __forceinline__ void f6_peer_naive(const Args& A, Frame& F) {
    const int* IDX = (const int*)(F.ws + WS_IDX); const float* GATE = (const float*)(F.ws + WS_GATE);
    f32x4 g2[4], gf[4];
#pragma unroll
    for (int j = 0; j < 4; ++j) { g2[j] = ((const f32x4*)A.in[12])[F.lane + 64 * j]; gf[j] = ((const f32x4*)A.in[17])[F.lane + 64 * j]; }
    for (int t = F.bid * NWAVES + F.wave; t < M; t += F.G * NWAVES) {
        f32x4* xr = (f32x4*)(F.out + (size_t)t * D) + F.lane;
        f32x4 x1[4], hn[4], y[4]; float ss = 0.f;
#pragma unroll
        for (int j = 0; j < 4; ++j) { x1[j] = xr[64 * j]; ss += (x1[j][0] * x1[j][0] + x1[j][1] * x1[j][1]) + (x1[j][2] * x1[j][2] + x1[j][3] * x1[j][3]); y[j] = (f32x4){0.f, 0.f, 0.f, 0.f}; }
        const float rstd = rsqrtf(wave_sum(ss) * (1.f / D) + EPS);
#pragma unroll
        for (int j = 0; j < 4; ++j) hn[j] = x1[j] * rstd * g2[j];
        const int ie0 = IDX[(size_t)t * 128 + F.lane], ie1 = IDX[(size_t)t * 128 + 64 + F.lane];
        const float ga0 = GATE[(size_t)t * 128 + F.lane], ga1 = GATE[(size_t)t * 128 + 64 + F.lane];
#pragma unroll 2
        for (int k = 0; k < 128; ++k) {
            const int e = __builtin_amdgcn_readlane(k < 64 ? ie0 : ie1, k & 63);
            const float gk = __uint_as_float(__builtin_amdgcn_readlane(__float_as_uint(k < 64 ? ga0 : ga1), k & 63));
            const f32x4* ur = (const f32x4*)(A.in[15] + (size_t)e * D) + F.lane; const f32x4* vr = (const f32x4*)(A.in[16] + (size_t)e * D) + F.lane;
            f32x4 u[4], vv[4]; float d = 0.f;
#pragma unroll
            for (int j = 0; j < 4; ++j) { u[j] = ur[64 * j]; vv[j] = vr[64 * j]; }
#pragma unroll
            for (int j = 0; j < 4; ++j) d += (hn[j][0] * u[j][0] + hn[j][1] * u[j][1]) + (hn[j][2] * u[j][2] + hn[j][3] * u[j][3]);
            d = wave_sum(d);
            const float coef = gk * 0.5f * d * (1.f + erff(d * 0.70710678118654752f));
#pragma unroll
            for (int j = 0; j < 4; ++j) y[j] = y[j] + vv[j] * coef;
        }
        float s2 = 0.f;
#pragma unroll
        for (int j = 0; j < 4; ++j) { x1[j] = x1[j] + y[j]; s2 += (x1[j][0] * x1[j][0] + x1[j][1] * x1[j][1]) + (x1[j][2] * x1[j][2] + x1[j][3] * x1[j][3]); }
        const float r2 = rsqrtf(wave_sum(s2) * (1.f / D) + EPS);
#pragma unroll
        for (int j = 0; j < 4; ++j) xr[64 * j] = x1[j] * r2 * gf[j];
    }
}

typedef float f32x2w __attribute__((ext_vector_type(2)));
__device__ __forceinline__ void sort128(unsigned& a, unsigned& b, int lane) {
#pragma unroll
    for (int k = 2; k <= 128; k <<= 1) {
#pragma unroll
        for (int j = k >> 1; j > 0; j >>= 1) {
            if (j == 64) { const unsigned lo = a < b ? a : b, hi = a < b ? b : a; a = lo; b = hi; }
            else {
                const unsigned oa = __shfl_xor(a, j), ob = __shfl_xor(b, j);
                const bool lower = (lane & j) == 0;
                const bool asc_a = (k == 128) ? true : ((lane & k) == 0), asc_b = (k == 128) ? true : ((lane & k) == 0);
                const bool aa = (k == 64) ? true : asc_a, ab = (k == 64) ? false : asc_b;
                const unsigned mna = a < oa ? a : oa, mxa = a < oa ? oa : a, mnb = b < ob ? b : ob, mxb = b < ob ? ob : b;
                a = (lower == aa) ? mna : mxa; b = (lower == ab) ? mnb : mxb;
            }
        }
    }
}
__device__ __forceinline__ void f6_load4(__amdgpu_buffer_rsrc_t TB, unsigned lb, unsigned key, int lbase, v4u (&r)[4], unsigned emask = 0x3fffu) {
#pragma unroll
    for (int k = 0; k < 4; ++k) { const unsigned e = ((unsigned)__builtin_amdgcn_readlane((int)key, lbase + k) >> 16) & emask; r[k] = __builtin_amdgcn_raw_buffer_load_b128(TB, (int)lb, (int)(e * (unsigned)D), 0); }
}
__device__ __forceinline__ float gelu_as(float v) {
    const float t = __builtin_amdgcn_rcpf(fabsf(v) * 0.2316418882f + 1.0f);
    float q = t * 0.5307027145f + (-0.7265760135f); q = q * t + 0.7107068705f; q = q * t + (-0.142248368f); q = q * t + 0.127414796f; q = q * t;
    const float m = v * (q * __builtin_amdgcn_exp2f(v * v * (-0.72134752044f)));
    return v < 0.f ? m : v - m;
}
__device__ __forceinline__ float f6_row16_sum(float v) {
    v += __uint_as_float(__builtin_amdgcn_update_dpp(0, __float_as_uint(v), 0xB1, 0xF, 0xF, true));
    v += __uint_as_float(__builtin_amdgcn_update_dpp(0, __float_as_uint(v), 0x4E, 0xF, 0xF, true));
    v += __uint_as_float(__builtin_amdgcn_update_dpp(0, __float_as_uint(v), 0x141, 0xF, 0xF, true));
    v += __uint_as_float(__builtin_amdgcn_update_dpp(0, __float_as_uint(v), 0x140, 0xF, 0xF, true));
    return v;
}
__device__ __forceinline__ float f6_coef4(const v4u (&u)[4], const LAS float* hxl, unsigned key, int lbase, int lane) {
    float hx[16];
#pragma unroll
    for (int j = 0; j < 4; ++j) { const f32x4 t = *(const LAS f32x4*)(hxl + 4 * j); hx[4 * j] = t[0]; hx[4 * j + 1] = t[1]; hx[4 * j + 2] = t[2]; hx[4 * j + 3] = t[3]; }
    float d[4];
#pragma unroll
    for (int k = 0; k < 4; ++k) { float s0 = 0.f, s1 = 0.f;
#pragma unroll
        for (int j = 0; j < 4; ++j) { const f32x2w lo = __builtin_amdgcn_cvt_pk_f32_fp8((int)u[k][j], false), hi = __builtin_amdgcn_cvt_pk_f32_fp8((int)u[k][j], true);
            s0 += lo.x * hx[4 * j] + hi.x * hx[4 * j + 2]; s1 += lo.y * hx[4 * j + 1] + hi.y * hx[4 * j + 3]; }
        d[k] = s0 + s1; }
    float s[4];
#pragma unroll
    for (int k = 0; k < 4; ++k) s[k] = f6_row16_sum(d[k]);
    float u2[2];
#pragma unroll
    for (int k = 0; k < 2; ++k) { const auto w = __builtin_amdgcn_permlane32_swap(__float_as_uint(s[k]), __float_as_uint(s[k + 2]), false, false);
        u2[k] = __uint_as_float(w[0]) + __uint_as_float(w[1]); }
    float r1;
    { const auto w = __builtin_amdgcn_permlane16_swap(__float_as_uint(u2[0]), __float_as_uint(u2[1]), false, false); r1 = __uint_as_float(w[0]) + __uint_as_float(w[1]); }
    r1 *= (1.f / EU_SCALE);
    float gk = 0.f;
#pragma unroll
    for (int k = 0; k < 4; ++k) { const float gg = __uint_as_float((unsigned)__builtin_amdgcn_readlane((int)key, lbase + k) << 16); gk = ((lane >> 4) == k) ? gg : gk; }
    return gk * gelu_as(r1) * (1.f / EV_SCALE);
}
__device__ __forceinline__ void f6_acc4(const v4u (&v)[4], float (&y)[16], float cf, int lbase) {
#pragma unroll
    for (int k = 0; k < 4; ++k) { const float c = __uint_as_float(__builtin_amdgcn_readlane(__float_as_uint(cf), lbase + k));
#pragma unroll
        for (int j = 0; j < 4; ++j) { const f32x2w lo = __builtin_amdgcn_cvt_pk_f32_fp8((int)v[k][j], false), hi = __builtin_amdgcn_cvt_pk_f32_fp8((int)v[k][j], true);
            y[4 * j] += c * lo.x; y[4 * j + 1] += c * lo.y; y[4 * j + 2] += c * hi.x; y[4 * j + 3] += c * hi.y; } }
}
__device__ __forceinline__ void f6_peer(const Args& A, Frame& F, bool dry, bool novalu = false, unsigned emask = 0x3fffu) {
    const GAS int* IDX = (const GAS int*)(F.ws + WS_IDX); const GAS float* GATE = (const GAS float*)(F.ws + WS_GATE);
    const __amdgpu_buffer_rsrc_t EU = __builtin_amdgcn_make_buffer_rsrc((void*)(F.ws + WS_EU), 0, NEXP * D, 0x00020000), EV = __builtin_amdgcn_make_buffer_rsrc((void*)(F.ws + WS_EV), 0, NEXP * D, 0x00020000);
    const int lane = F.lane, l16 = lane * 16; const unsigned lb = (unsigned)l16;
    LAS float* hxw = (LAS float*)(F.lds + F.wave * 16384);
#pragma unroll 1
    for (int base = (F.bid * NWAVES + F.wave) * 4; base < M; base += F.G * NWAVES * 4) {
        unsigned K0[4], K1[4];
#pragma unroll
        for (int q = 0; q < 4; ++q) { const int t = base + q; const GAS v4u* xp = (const GAS v4u*)((const GAS bf16*)F.out + (size_t)t * (2 * D) + D + l16);
            f32x4 a[4]; float ss = 0.f;
            { const v4u w0 = xp[0], w1 = xp[1];
              a[0] = (f32x4){blo(w0[0]), bhi(w0[0]), blo(w0[1]), bhi(w0[1])}; a[1] = (f32x4){blo(w0[2]), bhi(w0[2]), blo(w0[3]), bhi(w0[3])};
              a[2] = (f32x4){blo(w1[0]), bhi(w1[0]), blo(w1[1]), bhi(w1[1])}; a[3] = (f32x4){blo(w1[2]), bhi(w1[2]), blo(w1[3]), bhi(w1[3])}; }
#pragma unroll
            for (int j = 0; j < 4; ++j) ss += (a[j][0] * a[j][0] + a[j][1] * a[j][1]) + (a[j][2] * a[j][2] + a[j][3] * a[j][3]);
            const float rstd = rsqrtf(wave_sum(ss) * (1.f / D) + EPS);
#pragma unroll
            for (int j = 0; j < 4; ++j) { const f32x4 g2 = *(const f32x4*)(A.in[12] + l16 + 4 * j); f32x4 hv;
#pragma unroll
                for (int e = 0; e < 4; ++e) hv[e] = bf2f((unsigned short)f2bf(a[j][e] * rstd * g2[e]));
                *(LAS f32x4*)(hxw + q * 1024 + l16 + 4 * j) = hv; }
            unsigned ka = ((unsigned)IDX[(size_t)t * 128 + lane] << 16) | f2bf(GATE[(size_t)t * 128 + lane]), kb = ((unsigned)IDX[(size_t)t * 128 + 64 + lane] << 16) | f2bf(GATE[(size_t)t * 128 + 64 + lane]);
            sort128(ka, kb, lane);
            K0[q] = ka; K1[q] = kb; }
        LDS_WAIT();
#define F6_KEY(q_, g_) ((g_) < 16 ? K0[q_] : K1[q_])
#define F6_LB(g_) (((g_) & 15) * 4)
        float C0[4], C1[4];
#pragma unroll
        for (int q = 0; q < 4; ++q) { C0[q] = 0.f; C1[q] = 0.f; }
        { v4u ua[4], ub[4];
          f6_load4(EU, lb, K0[0], 0, ua, emask); f6_load4(EU, lb, K0[1], 0, ub, emask);
#pragma unroll 1
          for (int g = 0; g < ((emask == 1u) ? 0 : 32); ++g) {
#pragma unroll
              for (int q = 0; q < 4; ++q) {
                  const int lbase = F6_LB(g);
                  const float cf = f6_coef4((q & 1) ? ub : ua, hxw + q * 1024 + l16, F6_KEY(q, g), lbase, lane);
                  { const int gn = g + (q >= 2 ? 1 : 0), qn = (q + 2) & 3;
                    if (gn < 32) { if (q & 1) f6_load4(EU, lb, F6_KEY(qn, gn), F6_LB(gn), ub, emask); else f6_load4(EU, lb, F6_KEY(qn, gn), F6_LB(gn), ua, emask); } }
                  float mine = 0.f;
#pragma unroll
                  for (int k = 0; k < 4; ++k) { const float ck = __uint_as_float(__builtin_amdgcn_readlane(__float_as_uint(cf), 16 * k)); mine = (lane == lbase + k) ? ck : mine; }
                  const bool take = (unsigned)(lane - lbase) < 4u;
                  if (g < 16) C0[q] = take ? mine : C0[q]; else C1[q] = take ? mine : C1[q];
              }
          } }
        float y[4][16];
#pragma unroll
        for (int q = 0; q < 4; ++q)
#pragma unroll
            for (int j = 0; j < 16; ++j) y[q][j] = 0.f;
        { v4u va[4], vb[4];
          f6_load4(EV, lb, K0[0], 0, va, emask); f6_load4(EV, lb, K0[1], 0, vb, emask);
#pragma unroll 1
          for (int g = 0; g < ((emask == 1u || emask == 3u) ? 0 : 32); ++g) {
#pragma unroll
              for (int q = 0; q < 4; ++q) {
                  const int lbase = F6_LB(g);
                  if (!novalu) f6_acc4((q & 1) ? vb : va, y[q], g < 16 ? C0[q] : C1[q], lbase);
                  else { if (q & 1) { asm volatile("" :: "v"(vb[0]), "v"(vb[1]), "v"(vb[2]), "v"(vb[3])); } else { asm volatile("" :: "v"(va[0]), "v"(va[1]), "v"(va[2]), "v"(va[3])); } }
                  { const int gn = g + (q >= 2 ? 1 : 0), qn = (q + 2) & 3;
                    if (gn < 32) { if (q & 1) f6_load4(EV, lb, F6_KEY(qn, gn), F6_LB(gn), vb, emask); else f6_load4(EV, lb, F6_KEY(qn, gn), F6_LB(gn), va, emask); } }
              }
          } }
#undef F6_KEY
#undef F6_LB
#pragma unroll
        for (int q = 0; q < 4; ++q) { const int t = base + q; float* xr = F.out + (size_t)t * D + l16; float s2 = 0.f;
            { const GAS v4u* xp = (const GAS v4u*)((const GAS bf16*)F.out + (size_t)t * (2 * D) + D + l16); const v4u w0 = xp[0], w1 = xp[1];
#pragma unroll
              for (int e = 0; e < 4; ++e) { y[q][2 * e] += blo(w0[e]); y[q][2 * e + 1] += bhi(w0[e]); y[q][8 + 2 * e] += blo(w1[e]); y[q][8 + 2 * e + 1] += bhi(w1[e]); } }
#pragma unroll
            for (int j = 0; j < 16; ++j) s2 += y[q][j] * y[q][j];
            const float r2 = rsqrtf(wave_sum(s2) * (1.f / D) + EPS);
            float* xo = dry ? (float*)(F.ws + WS_Q2) + (size_t)t * D + l16 : xr;
#pragma unroll
            for (int j = 0; j < 4; ++j) { const f32x4 gf = *(const f32x4*)(A.in[17] + l16 + 4 * j);
                *(f32x4*)(xo + 4 * j) = (f32x4){y[q][4 * j] * r2 * gf[0], y[q][4 * j + 1] * r2 * gf[1], y[q][4 * j + 2] * r2 * gf[2], y[q][4 * j + 3] * r2 * gf[3]}; } }
        LDS_WAIT();
    }
}

typedef float f32x16 __attribute__((ext_vector_type(16)));
typedef float f32x2v __attribute__((ext_vector_type(2)));
typedef short bf16x8 __attribute__((ext_vector_type(8)));
#define MFMA32(a, b, c) __builtin_amdgcn_mfma_f32_32x32x16_bf16((a), (b), (c), 0, 0, 0)
__device__ __forceinline__ unsigned pkbf(float lo, float hi) { f32x2v v; v.x = lo; v.y = hi; return __builtin_bit_cast(unsigned, __builtin_convertvector(v, bf2_t)); }
__device__ __forceinline__ bf16x8 pack_step(const f32x16& x, int s) {
    v4u p; p.x = pkbf(x[8 * s], x[8 * s + 1]); p.y = pkbf(x[8 * s + 2], x[8 * s + 3]); p.z = pkbf(x[8 * s + 4], x[8 * s + 5]); p.w = pkbf(x[8 * s + 6], x[8 * s + 7]);
    return __builtin_bit_cast(bf16x8, p);
}
__device__ __forceinline__ int crow(int reg, int hh) { return (reg & 3) + 8 * (reg >> 2) + 4 * hh; }
__device__ __forceinline__ int toff(int row, int col) { return row * 256 + (((col >> 3) ^ (row & 15)) << 4) + ((col & 7) << 1); }

constexpr int NC = 32, NCH = TSEG / NC;
constexpr int NBLK_A = 36, NBLK_B = 28, REC_A = NBLK_A * 1024, REC_B = NBLK_B * 1024;
constexpr size_t WS_RECA = WS_PREP, WS_RECB = WS_PREP + (size_t)16 * NCH * REC_A;
static_assert(WS_RECB + (size_t)16 * NCH * REC_B <= 256 * MiB, "prep records fit");
constexpr int PW_BYTES = 16896;

__device__ __forceinline__ void prepA_chunk(const Args& A, Frame& F, int seg, int b, int h, int n, LAS unsigned char* wl) {
    int lane_ = F.lane; asm volatile("" : "+v"(lane_));
    const int lane = lane_, r = lane & 31, hh = lane >> 5, bh = b * NH + h;
    const GAS bf16* P = (const GAS bf16*)(F.ws + WS_P);
    GAS unsigned char* rec = (GAS unsigned char*)(F.ws + WS_RECA) + (size_t)(bh * NCH + n) * REC_A;
    GAS unsigned* histw = (GAS unsigned*)(F.ws + WS_HIST) + (size_t)((seg & 1) * 16 + bh) * 3 * 192;
    const GAS unsigned* histr = (const GAS unsigned*)(F.ws + WS_HIST) + (size_t)(((seg + 1) & 1) * 16 + bh) * 3 * 192;
    LAS unsigned char* QT = wl; LAS unsigned char* KT_ = wl + 8192; LAS float* sc = (LAS float*)(wl + 16384);
    const int t0 = n * NC, lr0 = b * TSEG + t0, g0 = b * T + seg * TSEG + t0;
    unsigned rawq[35], rawk[35], rawv[35];
#define PREP_LOAD(raw_, cb_, hoff_) do { unsigned voff = (unsigned)((lr0 - 3) * 16384 + (cb_) * 2);        \
        _Pragma("unroll") for (int i = 0; i < 35; ++i) { \
            if (i < 3 && n == 0) raw_[i] = seg ? histr[i * 192 + (hoff_) + lane] : 0u; \
            else raw_[i] = *(const GAS unsigned*)((const GAS unsigned char*)P + voff); \
            voff += 16384u; asm volatile("" : "+v"(voff)); } } while (0)
    PREP_LOAD(rawq, h * DH + 2 * lane, 0); PREP_LOAD(rawk, 1024 + h * DH + 2 * lane, 64); PREP_LOAD(rawv, 2048 + h * DH + 2 * lane, 128);
#undef PREP_LOAD
    __builtin_amdgcn_sched_barrier(0);
    if (n == NCH - 1) {
#pragma unroll
        for (int i = 0; i < 3; ++i) { histw[i * 192 + lane] = rawq[32 + i]; histw[i * 192 + 64 + lane] = rawk[32 + i]; histw[i * 192 + 128 + lane] = rawv[32 + i]; } }
#define PREP_CONV(raw_, cb_, tile_) do { float w0[4], w1[4]; \
        _Pragma("unroll") for (int j = 0; j < 4; ++j) { w0[j] = A.in[3][j * 3072 + (cb_)]; w1[j] = A.in[3][j * 3072 + (cb_) + 1]; } \
        _Pragma("unroll") for (int t = 0; t < 32; ++t) { \
            const float y0 = w0[0] * blo(raw_[t]) + w0[1] * blo(raw_[t + 1]) + w0[2] * blo(raw_[t + 2]) + w0[3] * blo(raw_[t + 3]); \
            const float y1 = w1[0] * bhi(raw_[t]) + w1[1] * bhi(raw_[t + 1]) + w1[2] * bhi(raw_[t + 2]) + w1[3] * bhi(raw_[t + 3]); \
            *(LAS unsigned*)((tile_) + toff(t, 2 * lane)) = pkbf(silu_f(y0), silu_f(y1)); } } while (0)
    PREP_CONV(rawq, h * DH + 2 * lane, QT);
    PREP_CONV(rawk, 1024 + h * DH + 2 * lane, KT_);
    float beta, G;
    { const GAS float* BA = (const GAS float*)(F.ws + WS_BA) + (size_t)(g0 + r) * 16;
      beta = sigmoid_f(BA[h]); G = -fexp(A.in[4][h]) * softplus_f(BA[8 + h] + A.in[5][h]);
#pragma unroll
      for (int o = 1; o < 32; o <<= 1) { const float up = __shfl_up(G, o, 32); if (r >= o) G += up; } }
    const float Glast = __shfl(G, 31, 32);
    if (lane < 32) { sc[r] = beta; sc[32 + r] = G; }
    LDS_WAIT();
    __builtin_amdgcn_sched_barrier(0);
    f32x16 KK, QKT, QQ;
#pragma unroll
    for (int i = 0; i < 16; ++i) { KK[i] = 0.f; QKT[i] = 0.f; QQ[i] = 0.f; }
#pragma unroll
    for (int kt = 0; kt < 8; ++kt) {
        const bf16x8 ak = *(const LAS bf16x8*)(KT_ + toff(r, 16 * kt + 8 * hh)), aq = *(const LAS bf16x8*)(QT + toff(r, 16 * kt + 8 * hh));
        KK = MFMA32(ak, ak, KK); QKT = MFMA32(ak, aq, QKT); QQ = MFMA32(aq, aq, QQ);
    }
    { float dk = 0.f, dq = 0.f;
#pragma unroll
      for (int reg = 0; reg < 16; ++reg) if (crow(reg, hh) == r) { dk = KK[reg]; dq = QQ[reg]; }
      if (hh == ((r >> 2) & 1)) { sc[64 + r] = rsqrtf(dk + EPS); sc[96 + r] = rsqrtf(dq + EPS) * 0.08838834764831845f; } }
    LDS_WAIT();
    const float rk_own = sc[64 + r], rq_own = sc[96 + r];
    f32x16 AK, X;
#pragma unroll
    for (int g4 = 0; g4 < 4; ++g4) {
        const f32x4 be4 = *(const LAS f32x4*)(sc + 8 * g4 + 4 * hh), G4 = *(const LAS f32x4*)(sc + 32 + 8 * g4 + 4 * hh), rk4 = *(const LAS f32x4*)(sc + 64 + 8 * g4 + 4 * hh);
#pragma unroll
        for (int e = 0; e < 4; ++e) { const int reg = 4 * g4 + e, row = 8 * g4 + 4 * hh + e;
            AK[reg] = (r < row) ? be4[e] * rk4[e] * rk_own * KK[reg] * fexp(G4[e] - G) : 0.f;
            X[reg] = (row <= r) ? rq_own * rk4[e] * QKT[reg] * fexp(G - G4[e]) : 0.f; }
    }
    __builtin_amdgcn_sched_barrier(0);
    float Tc[32];
#pragma unroll
    for (int i = 0; i < 32; ++i) {
        float acc = (i == r) ? 1.f : 0.f;
#pragma unroll
        for (int j = 0; j < i; ++j) { const float a = __uint_as_float(__builtin_amdgcn_readlane(__float_as_uint(AK[(i & 3) + 4 * (i >> 3)]), j + 32 * ((i >> 2) & 1))); acc -= a * Tc[j]; }
        Tc[i] = acc;
        __builtin_amdgcn_sched_barrier(0);
    }
    __builtin_amdgcn_sched_barrier(0);
    float T2[32];
    { const float fv = rk_own * fexp(Glast - G);
#pragma unroll
      for (int i = 0; i < 32; ++i) { Tc[i] *= beta; T2[i] = Tc[i] * __uint_as_float(__builtin_amdgcn_readlane(__float_as_uint(fv), i)); } }
    bf16x8 aT1[2], aT2[2];
#pragma unroll
    for (int s = 0; s < 2; ++s) { v4u p1, p2;
#pragma unroll
        for (int q = 0; q < 4; ++q) { const int ja = 16 * s + 8 * ((2 * q) >> 2) + ((2 * q) & 3), jb = ja + 1;
            p1[q] = hh ? pkbf(Tc[ja + 4], Tc[jb + 4]) : pkbf(Tc[ja], Tc[jb]); p2[q] = hh ? pkbf(T2[ja + 4], T2[jb + 4]) : pkbf(T2[ja], T2[jb]); }
        aT1[s] = __builtin_bit_cast(bf16x8, p1); aT2[s] = __builtin_bit_cast(bf16x8, p2); }
    __builtin_amdgcn_sched_barrier(0);
    { f32x16 W;
#pragma unroll
      for (int i = 0; i < 16; ++i) W[i] = 0.f;
#pragma unroll
      for (int s = 0; s < 2; ++s) W = MFMA32(aT1[s], pack_step(X, s), W);
#pragma unroll
      for (int s = 0; s < 2; ++s) *(GAS bf16x8*)(rec + (24 + s) * 1024 + lane * 16) = pack_step(W, s); }
    __builtin_amdgcn_sched_barrier(0);
#pragma unroll
    for (int mt = 0; mt < 4; ++mt) { f32x16 Kt;
#pragma unroll
        for (int i = 0; i < 16; ++i) Kt[i] = 0.f;
#pragma unroll
        for (int s = 0; s < 2; ++s) { v4u p;
#pragma unroll
            for (int q = 0; q < 4; ++q) { const int ja = 16 * s + 8 * ((2 * q) >> 2) + 4 * hh + ((2 * q) & 3);
                const unsigned lo = *(const LAS unsigned short*)(KT_ + toff(ja, 32 * mt + r)), hi = *(const LAS unsigned short*)(KT_ + toff(ja + 1, 32 * mt + r)); p[q] = lo | (hi << 16); }
            Kt = MFMA32(aT2[s], __builtin_bit_cast(bf16x8, p), Kt); }
#pragma unroll
        for (int s = 0; s < 2; ++s) *(GAS bf16x8*)(rec + (16 + 2 * mt + s) * 1024 + lane * 16) = pack_step(Kt, s); }
    __builtin_amdgcn_sched_barrier(0);
    { const float eg = fexp(G), fk = -rk_own * eg, fq = rq_own * eg;
#pragma unroll
      for (int kt = 0; kt < 8; ++kt) { const int c0 = 16 * kt + 4 * hh;
          const v2u k0 = *(const LAS v2u*)(KT_ + toff(r, c0)), k1 = *(const LAS v2u*)(KT_ + toff(r, c0 + 8)), q0 = *(const LAS v2u*)(QT + toff(r, c0)), q1 = *(const LAS v2u*)(QT + toff(r, c0 + 8));
          v4u ko, qo;
          ko.x = pkbf(blo(k0.x) * fk, bhi(k0.x) * fk); ko.y = pkbf(blo(k0.y) * fk, bhi(k0.y) * fk); ko.z = pkbf(blo(k1.x) * fk, bhi(k1.x) * fk); ko.w = pkbf(blo(k1.y) * fk, bhi(k1.y) * fk);
          qo.x = pkbf(blo(q0.x) * fq, bhi(q0.x) * fq); qo.y = pkbf(blo(q0.y) * fq, bhi(q0.y) * fq); qo.z = pkbf(blo(q1.x) * fq, bhi(q1.x) * fq); qo.w = pkbf(blo(q1.y) * fq, bhi(q1.y) * fq);
          *(GAS v4u*)(rec + kt * 1024 + lane * 16) = ko; *(GAS v4u*)(rec + (8 + kt) * 1024 + lane * 16) = qo; } }
    if (lane == 0) *(GAS float*)(rec + 34 * 1024) = fexp(Glast);
    LDS_WAIT();
    PREP_CONV(rawv, 2048 + h * DH + 2 * lane, QT);
#undef PREP_CONV
    LDS_WAIT();
#pragma unroll
    for (int w = 0; w < 4; ++w) { v4u lo4, hi4;
#pragma unroll
        for (int q = 0; q < 8; ++q) { const unsigned a = *(const LAS unsigned short*)(QT + toff(crow(2 * q, hh), 32 * w + r)), bq = *(const LAS unsigned short*)(QT + toff(crow(2 * q + 1, hh), 32 * w + r));
            if (q < 4) lo4[q] = a | (bq << 16); else hi4[q - 4] = a | (bq << 16); }
        *(GAS v4u*)(rec + (26 + 2 * w) * 1024 + lane * 16) = lo4; *(GAS v4u*)(rec + (27 + 2 * w) * 1024 + lane * 16) = hi4; }
    LDS_WAIT();
}

constexpr int RING_SLOT = 36864, RING_SLOTS = 3, GRING_OFF = RING_SLOT * RING_SLOTS, GSLOT = 8192, OBUF_OFF = GRING_OFF + 3 * GSLOT, OBUF_BYTES = 32 * 128 * 2;
static_assert(OBUF_OFF + 2 * OBUF_BYTES <= MISC_OFF, "scan LDS map");
#define RAW_BAR() do { asm volatile("" ::: "memory"); __builtin_amdgcn_s_barrier(); asm volatile("" ::: "memory"); } while (0)

__device__ __forceinline__ float row16_sum(float v) {
    v += __uint_as_float(__builtin_amdgcn_update_dpp(0, __float_as_uint(v), 0xB1, 0xF, 0xF, true));
    v += __uint_as_float(__builtin_amdgcn_update_dpp(0, __float_as_uint(v), 0x4E, 0xF, 0xF, true));
    v += __uint_as_float(__builtin_amdgcn_update_dpp(0, __float_as_uint(v), 0x141, 0xF, 0xF, true));
    v += __uint_as_float(__builtin_amdgcn_update_dpp(0, __float_as_uint(v), 0x140, 0xF, 0xF, true));
    return v;
}
__device__ __forceinline__ void scan_post_chunk(Frame& F, const LAS unsigned char* ob, const LAS unsigned char* gs, int hw, int g0, int h, const float (&wn)[8], bf16* O, bool dry) {
    const int tsub = F.lane >> 4, dg = F.lane & 15;
#pragma unroll
    for (int ps = 0; ps < 2; ++ps) { const int tk = 8 * hw + 4 * ps + tsub;
        const v4u ow = *(const LAS v4u*)(ob + tk * 256 + dg * 16), gw = *(const LAS v4u*)(gs + tk * 256 + dg * 16);
        float a[8];
#pragma unroll
        for (int q = 0; q < 4; ++q) { a[2 * q] = blo(ow[q]); a[2 * q + 1] = bhi(ow[q]); }
        const float ss = row16_sum((a[0] * a[0] + a[1] * a[1]) + (a[2] * a[2] + a[3] * a[3]) + (a[4] * a[4] + a[5] * a[5]) + (a[6] * a[6] + a[7] * a[7]));
        const float rstd = rsqrtf(ss * (1.f / 128.f) + EPS);
        v4u o;
#pragma unroll
        for (int q = 0; q < 4; ++q) o[q] = pkbf(a[2 * q] * rstd * wn[2 * q] * blo(gw[q]), a[2 * q + 1] * rstd * wn[2 * q + 1] * bhi(gw[q]));
        bf16* Ow = dry ? (bf16*)(F.ws + 244 * MiB) + (size_t)((g0 + tk) & 4095) * D : O + (size_t)(g0 + tk) * D;
        *(GAS v4u*)(Ow + h * DH + 8 * dg) = o; }
}
template <int BR  >
__device__ __forceinline__ void scan_mfma(const Args& A, Frame& F, int seg, int b, int h, bool dry, int dflags = 0) {
    constexpr int NBLK = BR ? NBLK_B : NBLK_A, REC = NBLK * 1024, NLQ = NBLK / 4;
    const int bh = b * NH + h, lane = F.lane, wv = F.wave, r = lane & 31, hh = lane >> 5;
    const GAS unsigned char* recs = (const GAS unsigned char*)(F.ws + (BR ? WS_RECB : WS_RECA)) + (size_t)bh * NCH * REC;
    LAS unsigned char* ring = F.lds; LAS unsigned char* gring = F.lds + GRING_OFF; LAS unsigned char* obuf = F.lds + OBUF_OFF;
    if (wv < 4) {
        GAS float* ST = (GAS float*)(F.ws + WS_STATE) + (size_t)(BR * 16 + bh) * DH * DH + (size_t)wv * 4096;
        f32x16 S[4];
#pragma unroll
        for (int mt = 0; mt < 4; ++mt)
#pragma unroll
            for (int i = 0; i < 16; ++i) S[mt][i] = seg ? ST[(mt * 16 + i) * 64 + lane] : 0.f;
        __builtin_amdgcn_s_setprio(2);
        RAW_BAR();
#pragma unroll 1
        for (int n = 0; n < NCH; ++n) {
            const LAS unsigned char* sl = ring + (n % RING_SLOTS) * RING_SLOT + lane * 16; LAS unsigned char* ob = obuf + (n & 1) * OBUF_BYTES;
#define LDF(blk) (*(const LAS bf16x8*)(sl + (blk) * 1024))
            constexpr int PF = 6, NSTEP = BR ? 18 : 26;
            bf16x8 f[NSTEP], Sb[8];
            f32x16 o;
#pragma unroll
            for (int i = 0; i < 16; ++i) o[i] = 0.f;
            if constexpr (BR == 0) {
                const v4u v0 = *(const LAS v4u*)(sl + (26 + 2 * wv) * 1024), v1 = *(const LAS v4u*)(sl + (27 + 2 * wv) * 1024);
                const float gl = *(const LAS float*)(ring + (n % RING_SLOTS) * RING_SLOT + 34 * 1024);
#define BLKA(i) ((i) < 16 ? (i) : ((i) < 18 ? (i) + 8 : (i) - 2))
#pragma unroll
                for (int i = 0; i < PF; ++i) f[i] = LDF(BLKA(i));
                f32x16 R; bf16x8 Rb0, Rb1;
#pragma unroll
                for (int q = 0; q < 4; ++q) { R[2 * q] = blo(v0[q]); R[2 * q + 1] = bhi(v0[q]); R[8 + 2 * q] = blo(v1[q]); R[8 + 2 * q + 1] = bhi(v1[q]); }
#pragma unroll
                for (int i = 0; i < NSTEP; ++i) {
                    if (i + PF < NSTEP) f[i + PF] = LDF(BLKA(i + PF));
                    if (i < 8) { Sb[i] = pack_step(S[i >> 1], i & 1); R = MFMA32(f[i], Sb[i], R); }
                    else if (i < 16) { o = MFMA32(f[i], Sb[i - 8], o);
#pragma unroll
                        for (int e = 0; e < 8; ++e) S[(i - 8) >> 1][8 * ((i - 8) & 1) + e] *= gl; }
                    else if (i == 16) { Rb0 = pack_step(R, 0); Rb1 = pack_step(R, 1); o = MFMA32(f[i], Rb0, o); }
                    else if (i == 17) o = MFMA32(f[i], Rb1, o);
                    else S[(i - 18) >> 1] = MFMA32(f[i], ((i - 18) & 1) ? Rb1 : Rb0, S[(i - 18) >> 1]);
                    __builtin_amdgcn_sched_barrier(0);
                }
#undef BLKA
            } else {
                const bf16x8 Vb0 = *(const LAS bf16x8*)(sl + (18 + 2 * wv) * 1024), Vb1 = *(const LAS bf16x8*)(sl + (19 + 2 * wv) * 1024);
                const LAS float* gd = (const LAS float*)(ring + (n % RING_SLOTS) * RING_SLOT + 26 * 1024);
#define BLKB(i) ((i) < 8 ? (i) : ((i) < 10 ? (i) + 8 : (i) - 2))
#pragma unroll
                for (int i = 0; i < PF; ++i) f[i] = LDF(BLKB(i));
#pragma unroll
                for (int i = 0; i < NSTEP; ++i) {
                    if (i + PF < NSTEP) f[i + PF] = LDF(BLKB(i + PF));
                    if (i < 8) { Sb[i] = pack_step(S[i >> 1], i & 1); o = MFMA32(f[i], Sb[i], o);
                        const f32x4 ga = *(const LAS f32x4*)(gd + 32 * (i >> 1) + 16 * (i & 1) + 4 * hh), gb = *(const LAS f32x4*)(gd + 32 * (i >> 1) + 16 * (i & 1) + 8 + 4 * hh);
#pragma unroll
                        for (int e = 0; e < 4; ++e) { S[i >> 1][8 * (i & 1) + e] *= ga[e]; S[i >> 1][8 * (i & 1) + 4 + e] *= gb[e]; } }
                    else if (i == 8) o = MFMA32(f[i], Vb0, o);
                    else if (i == 9) o = MFMA32(f[i], Vb1, o);
                    else S[(i - 10) >> 1] = MFMA32(f[i], ((i - 10) & 1) ? Vb1 : Vb0, S[(i - 10) >> 1]);
                    __builtin_amdgcn_sched_barrier(0);
                }
#undef BLKB
            }
#undef LDF
#pragma unroll
            for (int i = 0; i < 16; ++i) *(LAS unsigned short*)(ob + crow(i, hh) * 256 + (32 * wv + r) * 2) = (unsigned short)pkbf(o[i], 0.f);
            LDS_WAIT(); RAW_BAR();
        }
        __builtin_amdgcn_s_setprio(0);
#pragma unroll
        for (int mt = 0; mt < 4; ++mt)
#pragma unroll
            for (int i = 0; i < 16; ++i) if (!dry) ST[(mt * 16 + i) * 64 + lane] = S[mt][i];
    } else {
        const int hw = wv - 4; float wn[8];
        { const float* onw = A.in[BR ? 8 : 6] + 8 * (lane & 15);
#pragma unroll
          for (int j = 0; j < 8; ++j) wn[j] = onw[j]; }
        bf16* O = (bf16*)(F.ws + (BR ? WS_OB : WS_OA)); const int gbase = b * T + seg * TSEG;
        const GAS unsigned char* gsrc = (const GAS unsigned char*)O + (size_t)gbase * (D * 2) + h * (DH * 2) + (size_t)(lane >> 4) * (D * 2) + (lane & 15) * 16;
        asm volatile("s_waitcnt vmcnt(0)" ::: "memory");
#define ISSUE_REC(nn) do { if (dflags & 2) break; const GAS unsigned char* rp_ = recs + (size_t)(nn) * REC + lane * 16; LAS unsigned char* dp_ = ring + ((nn) % RING_SLOTS) * RING_SLOT; \
        _Pragma("unroll") for (int k_ = 0; k_ < NLQ; ++k_) __builtin_amdgcn_global_load_lds((const GAS unsigned*)(rp_ + (hw + 4 * k_) * 1024), (LAS unsigned*)(dp_ + (hw + 4 * k_) * 1024), 16, 0, 0); } while (0)
#define ISSUE_GATE(cc) do { if (dflags & 2) break; const GAS unsigned char* gp_ = gsrc + (size_t)((cc) * NC + 8 * hw) * (D * 2); LAS unsigned char* dp_ = gring + ((cc) % 3) * GSLOT + 2 * hw * 1024; \
        __builtin_amdgcn_global_load_lds((const GAS unsigned*)gp_, (LAS unsigned*)dp_, 16, 0, 0); __builtin_amdgcn_global_load_lds((const GAS unsigned*)(gp_ + 4 * (D * 2)), (LAS unsigned*)(dp_ + 1024), 16, 0, 0); } while (0)
#define WAIT_OLDER() do { if constexpr (NLQ == 9) asm volatile("s_waitcnt vmcnt(11)" ::: "memory"); else asm volatile("s_waitcnt vmcnt(9)" ::: "memory"); } while (0)
        ISSUE_REC(0); ISSUE_REC(1); ISSUE_GATE(0);
        WAIT_OLDER();
        RAW_BAR();
#pragma unroll 1
        for (int n = 0; n < NCH; ++n) {
            if (n + 2 < NCH) ISSUE_REC(n + 2);
            if (n + 1 < NCH) ISSUE_GATE(n + 1);
            if (n >= 1 && !(dflags & 1)) scan_post_chunk(F, obuf + ((n - 1) & 1) * OBUF_BYTES, gring + ((n - 1) % 3) * GSLOT, hw, gbase + (n - 1) * NC, h, wn, O, dry);
            if (n + 2 < NCH) WAIT_OLDER(); else asm volatile("s_waitcnt vmcnt(0)" ::: "memory");
            LDS_WAIT(); RAW_BAR();
        }
        if (!(dflags & 1)) scan_post_chunk(F, obuf + ((NCH - 1) & 1) * OBUF_BYTES, gring + ((NCH - 1) % 3) * GSLOT, hw, gbase + (NCH - 1) * NC, h, wn, O, dry);
#undef ISSUE_REC
#undef ISSUE_GATE
#undef WAIT_OLDER
    }
    __syncthreads();
}

__device__ __forceinline__ void prepB_chunk(const Args& A, Frame& F, int seg, int b, int h, int n, LAS unsigned char* wl) {
    int lane_ = F.lane; asm volatile("" : "+v"(lane_));
    const int lane = lane_, r = lane & 31, hh = lane >> 5, bh = b * NH + h;
    const GAS bf16* P = (const GAS bf16*)(F.ws + WS_P);
    GAS unsigned char* rec = (GAS unsigned char*)(F.ws + WS_RECB) + (size_t)(bh * NCH + n) * REC_B;
    LAS unsigned char* QB = wl; LAS unsigned char* KB = wl + 8192; LAS float* gd = (LAS float*)(wl + 16384);
    const int lr0 = b * TSEG + n * NC;
    { const int c2 = h * DH + 2 * lane;
      const float la0 = A.in[7][c2], la1 = A.in[7][c2 + 1], lc0 = A.in[7][1024 + c2], lc1 = A.in[7][1024 + c2 + 1];
      const float lb0 = 1.f / (1.f + fexp(lc0 - la0)), lb1 = 1.f / (1.f + fexp(lc1 - la1));
      unsigned rf[32], rq[32]; unsigned voff = (unsigned)(lr0 * 16384 + (4096 + c2) * 2);
#pragma unroll
      for (int i = 0; i < 32; ++i) { rf[i] = *(const GAS unsigned*)((const GAS unsigned char*)P + voff); rq[i] = *(const GAS unsigned*)((const GAS unsigned char*)P + voff + 4096); voff += 16384u; asm volatile("" : "+v"(voff)); }
      float b0 = 0.f, b1 = 0.f;
#pragma unroll
      for (int t = 0; t < 32; ++t) {
          const float f0 = lb0 + (1.f - lb0) * sigmoid_f(blo(rf[t])), f1 = lb1 + (1.f - lb1) * sigmoid_f(bhi(rf[t]));
          b0 += __builtin_amdgcn_logf(f0) * 0.6931471805599453f; b1 += __builtin_amdgcn_logf(f1) * 0.6931471805599453f;
          *(LAS unsigned*)(QB + toff(t, 2 * lane)) = pkbf(silu_f(blo(rq[t])) * fexp(b0), silu_f(bhi(rq[t])) * fexp(b1));
          *(LAS unsigned*)(KB + toff(t, 2 * lane)) = pkbf((1.f - f0) * fexp(-b0), (1.f - f1) * fexp(-b1));
      }
      const float g0 = fexp(b0), g1 = fexp(b1);
      gd[2 * lane] = g0; gd[2 * lane + 1] = g1;
      *(GAS f32x2v*)(rec + 26 * 1024 + lane * 8) = (f32x2v){g0, g1}; }
    LDS_WAIT();
    __builtin_amdgcn_sched_barrier(0);
    { f32x16 X;
#pragma unroll
      for (int i = 0; i < 16; ++i) X[i] = 0.f;
#pragma unroll
      for (int kt = 0; kt < 8; ++kt) X = MFMA32(*(const LAS bf16x8*)(KB + toff(r, 16 * kt + 8 * hh)), *(const LAS bf16x8*)(QB + toff(r, 16 * kt + 8 * hh)), X);
#pragma unroll
      for (int i = 0; i < 16; ++i) X[i] = (crow(i, hh) <= r) ? X[i] : 0.f;
#pragma unroll
      for (int s = 0; s < 2; ++s) *(GAS bf16x8*)(rec + (16 + s) * 1024 + lane * 16) = pack_step(X, s); }
#pragma unroll
    for (int kt = 0; kt < 8; ++kt) { const int c0 = 16 * kt + 4 * hh;
        const v2u q0 = *(const LAS v2u*)(QB + toff(r, c0)), q1 = *(const LAS v2u*)(QB + toff(r, c0 + 8));
        v4u qo; qo.x = q0.x; qo.y = q0.y; qo.z = q1.x; qo.w = q1.y;
        *(GAS v4u*)(rec + kt * 1024 + lane * 16) = qo; }
#pragma unroll
    for (int mt = 0; mt < 4; ++mt) { const float gg = gd[32 * mt + r];
#pragma unroll
        for (int s = 0; s < 2; ++s) { v4u p;
#pragma unroll
            for (int q = 0; q < 4; ++q) { const int ja = 16 * s + 8 * ((2 * q) >> 2) + 4 * hh + ((2 * q) & 3);
                const unsigned short lo = *(const LAS unsigned short*)(KB + toff(ja, 32 * mt + r)), hi = *(const LAS unsigned short*)(KB + toff(ja + 1, 32 * mt + r));
                p[q] = pkbf(bf2f(lo) * gg, bf2f(hi) * gg); }
            *(GAS v4u*)(rec + (8 + 2 * mt + s) * 1024 + lane * 16) = p; } }
#pragma unroll
    for (int w = 0; w < 4; ++w) { v4u lo4, hi4; const GAS bf16* vp = P + (size_t)lr0 * 8192 + 5120 + h * DH + 32 * w + r;
#pragma unroll
        for (int q = 0; q < 8; ++q) { const unsigned a = vp[(size_t)crow(2 * q, hh) * 8192], bq = vp[(size_t)crow(2 * q + 1, hh) * 8192];
            if (q < 4) lo4[q] = a | (bq << 16); else hi4[q - 4] = a | (bq << 16); }
        *(GAS v4u*)(rec + (18 + 2 * w) * 1024 + lane * 16) = lo4; *(GAS v4u*)(rec + (19 + 2 * w) * 1024 + lane * 16) = hi4; }
    LDS_WAIT();
}

#define CE_D(a, b) do { const float hi_ = fmaxf(a, b), lo_ = fminf(a, b); a = hi_; b = lo_; } while (0)
#define CE_A(a, b) do { const float hi_ = fmaxf(a, b), lo_ = fminf(a, b); a = lo_; b = hi_; } while (0)
__device__ __forceinline__ void sort16_desc(float (&v)[64], const int base) {
#pragma unroll
    for (int k = 2; k <= 16; k <<= 1)
#pragma unroll
        for (int j = k >> 1; j > 0; j >>= 1)
#pragma unroll
            for (int i = 0; i < 16; ++i) { const int l = i ^ j; if (l > i) { if ((i & k) == 0) CE_D(v[base + i], v[base + l]); else CE_A(v[base + i], v[base + l]); } }
}
__device__ __forceinline__ void merge16_desc(float (&v)[64], const int base) {
#pragma unroll
    for (int j = 8; j > 0; j >>= 1)
#pragma unroll
        for (int i = 0; i < 16; ++i) { const int l = i ^ j; if (l > i) CE_D(v[base + i], v[base + l]); }
}
__device__ __forceinline__ void top16_of_64(float (&v)[64]) {
    sort16_desc(v, 0); sort16_desc(v, 16); sort16_desc(v, 32); sort16_desc(v, 48);
#pragma unroll
    for (int i = 0; i < 16; ++i) { v[i] = fmaxf(v[i], v[31 - i]); v[32 + i] = fmaxf(v[32 + i], v[63 - i]); }
    merge16_desc(v, 0); merge16_desc(v, 32);
#pragma unroll
    for (int i = 0; i < 16; ++i) v[i] = fmaxf(v[i], v[47 - i]);
    merge16_desc(v, 0);
}
__device__ __forceinline__ void f5_topk(const Args& A, Frame& F) {
    const GAS bf16* SKb = (const GAS bf16*)(F.ws + WS_SK); const GAS bf16* Q2 = (const GAS bf16*)(F.ws + WS_Q2);
    GAS int* IDX = (GAS int*)(F.ws + WS_IDX); GAS float* GATE = (GAS float*)(F.ws + WS_GATE);
    LAS unsigned char* skl = F.lds;
    LAS float* wl = (LAS float*)(F.lds + 69632 + F.wave * 8448);
    LAS unsigned char* tab = F.lds + 69632 + 8 * 8448;
    const int lane = F.lane, r = lane & 31, hh = lane >> 5;
    if (F.tid < 64) { int cid = 0, val = 0;
        for (int i = 0; i < 16; ++i) for (int j = 0; j < 16 / (i + 1); ++j) { if (cid == F.tid) val = (i << 4) | j; ++cid; }
        tab[F.tid] = (unsigned char)val; }
    for (int item = F.bid; item < 8 * 32; item += F.G) {
        const int h = item & 7, grp = item >> 3;
        __syncthreads();
        for (int e = F.tid; e < 2 * 128 * 16; e += NTHREADS) { const int p = e >> 11, k = (e >> 4) & 127, ch = e & 15;
            *(LAS v4u*)(skl + p * 34816 + k * 272 + ch * 16) = *(const GAS v4u*)(SKb + ((size_t)(p * 8 + h) * 128 + k) * 128 + ch * 8); }
        __syncthreads();
#pragma unroll 1
        for (int tl = 0; tl < 2; ++tl) {
            const int t = grp * 512 + (F.wave * 2 + tl) * 32 + r;
            float lst[2][16];
#pragma unroll
            for (int p = 0; p < 2; ++p) {
                f32x16 acc[4];
#pragma unroll
                for (int tile = 0; tile < 4; ++tile)
#pragma unroll
                    for (int i = 0; i < 16; ++i) acc[tile][i] = 0.f;
#pragma unroll
                for (int kt = 0; kt < 8; ++kt) {
                    const bf16x8 bq = *(const GAS bf16x8*)(Q2 + (size_t)t * 2048 + h * 256 + p * 128 + 16 * kt + 8 * hh);
#pragma unroll
                    for (int tile = 0; tile < 4; ++tile) acc[tile] = MFMA32(*(const LAS bf16x8*)(skl + p * 34816 + (32 * tile + r) * 272 + (16 * kt + 8 * hh) * 2), bq, acc[tile]);
                }
                float v[64];
#pragma unroll
                for (int tile = 0; tile < 4; ++tile)
#pragma unroll
                    for (int i = 0; i < 16; ++i) v[16 * tile + i] = __uint_as_float((__float_as_uint(acc[tile][i]) & ~127u) | (unsigned)(32 * tile + crow(i, hh)));
                top16_of_64(v);
#pragma unroll
                for (int i = 0; i < 16; ++i) v[16 + i] = __shfl_xor(v[i], 32);
#pragma unroll
                for (int i = 0; i < 16; ++i) v[i] = fmaxf(v[i], v[31 - i]);
                merge16_desc(v, 0);
#pragma unroll
                for (int i = 0; i < 16; ++i) lst[p][i] = v[i];
            }
            float c[64]; { int cid = 0;
#pragma unroll
                for (int i = 0; i < 16; ++i)
#pragma unroll
                    for (int j = 0; j < 16 / (i + 1); ++j) { c[cid] = __uint_as_float((__float_as_uint(lst[0][i] + lst[1][j]) & ~63u) | (unsigned)cid); ++cid; }
#pragma unroll
                for (int q = 50; q < 64; ++q) c[q] = -3.0e38f; }
            top16_of_64(c);
#pragma unroll
            for (int i = 0; i < 16; ++i) { wl[lane * 33 + i] = lst[0][i]; wl[lane * 33 + 16 + i] = lst[1][i]; }
            LDS_WAIT();
            float esum = 0.f, ex[16]; int id[16];
#pragma unroll
            for (int i = 0; i < 16; ++i) { ex[i] = __expf(c[i] - c[0]); esum += ex[i];
                const int ij = tab[__float_as_uint(c[i]) & 63u];
                const unsigned a = __float_as_uint(wl[lane * 33 + (ij >> 4)]), bq = __float_as_uint(wl[lane * 33 + 16 + (ij & 15)]);
                id[i] = (int)((a & 127u) * 128u + (bq & 127u)); }
            const float inv = 1.f / esum;
            if (hh == 0) {
#pragma unroll
                for (int q = 0; q < 4; ++q) *(GAS v4u*)(IDX + (size_t)t * 128 + h * 16 + 4 * q) = (v4u){(unsigned)id[4 * q], (unsigned)id[4 * q + 1], (unsigned)id[4 * q + 2], (unsigned)id[4 * q + 3]};
            } else {
#pragma unroll
                for (int q = 0; q < 4; ++q) *(GAS f32x4*)(GATE + (size_t)t * 128 + h * 16 + 4 * q) = (f32x4){ex[4 * q] * inv, ex[4 * q + 1] * inv, ex[4 * q + 2] * inv, ex[4 * q + 3] * inv};
            }
            LDS_WAIT();
        }
    }
}

constexpr int NPHASE = 16;
#ifndef PG8_ALIGN
#define PG8_ALIGN true
#endif
#ifndef PG8_SP2
#define PG8_SP2 true
#endif

__global__ void __launch_bounds__(NTHREADS, 2) mk_fwd(const Args args) {
    extern __shared__ __attribute__((aligned(16))) unsigned char lds[];
    Frame F;
    F.lds = (LAS unsigned char*)lds;
    F.tid = threadIdx.x; F.lane = F.tid & 63; F.wave = __builtin_amdgcn_readfirstlane(F.tid >> 6);
    F.G = gridDim.x; F.bid = blockIdx.x;
    F.ws = args.ws; F.out = args.out;
    for (int u = F.tid; u < (LDS_BYTES - MISC_OFF) / 4; u += NTHREADS) ((LAS unsigned*)(F.lds + MISC_OFF))[u] = 0u;
    __syncthreads();
    XcdBarrier bar; bar.bar = (unsigned*)(args.ws + WS_CTL) + CW_BAR; bar.x = 0; bar.st = nullptr;
    if (args.use_bar) bar = xcd_barrier_post((unsigned*)(args.ws + WS_CTL) + CW_BAR, (volatile LAS unsigned*)(F.lds + MISC_OFF) + 8);
    const int lo = args.ph_lo, hi = args.ph_hi;
#define IN(k) (lo <= (k) && (k) < hi)
#define REFRESH() do { int t_ = threadIdx.x; asm volatile("" : "+v"(t_)); F.tid = t_; F.lane = t_ & 63; F.wave = __builtin_amdgcn_readfirstlane(t_ >> 6); \
        unsigned char* w_ = args.ws; asm volatile("" : "+s"(w_)); F.ws = w_; float* o_ = args.out; asm volatile("" : "+s"(o_)); F.out = o_; \
        int b_ = blockIdx.x; asm volatile("" : "+s"(b_)); F.bid = b_; } while (0)
#ifdef REP_EXP
#define REPLOOP(k) for (int it_ = 0, nrep_ = (args.pad == (k) ? 2 : 1); it_ < nrep_; ++it_)
#define DRY(k) (args.pad == (k) && it_ == 0)
#else
#define REPLOOP(k)
#define DRY(k) false
#endif
#define SEAM(k) do { if (IN(k) && IN((k) + 1)) xcd_barrier(bar); } while (0)

    if (IN(0)) REPLOOP(100) {
        REFRESH();
        p0_weights(args, F, 0, F.bid, F.G);
        __syncthreads();
        norm_rows(args, F, 0, (bf16*)(F.ws + WS_XN), F.bid, F.G);
    }
    SEAM(0);
    if (IN(1)) REPLOOP(101) {
        REFRESH();
        if (F.bid < F.G - 32) {
            pg8::Gemm g{(const bf16*)(F.ws + WS_XN), (const bf16*)(F.ws + WS_WIN), MSEG, NPROJ, D}; pg8::StaticOrder S; S.init(MSEG, NPROJ, F.G - 32, F.bid);
            pg8::EpiP1 E{(bf16*)(F.ws + WS_P), (bf16*)F.out, (bf16*)(F.ws + WS_OA), (bf16*)(F.ws + WS_OB), (float*)(F.ws + WS_BA), 0};
            pg8::gemm_phase<pg8::EpiP1, pg8::StaticOrder, PG8_ALIGN, PG8_SP2>(F.lds, g, S, E);
        } else { p0_weights(args, F, 1, F.bid - (F.G - 32), 32); norm_rows(args, F, 1, (bf16*)(F.ws + WS_XN) + (size_t)MSEG * D, F.bid - (F.G - 32), 32); }
    }
    SEAM(1);
    for (int s = 0; s < NSEG; ++s) {
        if (IN(2 + 2 * s)) REPLOOP(102) {
            REFRESH();
            for (int id = F.bid * NWAVES + F.wave; id < 2 * 16 * NCH; id += F.G * NWAVES) {
                if (id < 16 * NCH) prepA_chunk(args, F, s, id >> 9, (id >> 6) & 7, id & 63, F.lds + F.wave * PW_BYTES);
                else prepB_chunk(args, F, s, (id >> 9) & 1, (id >> 6) & 7, id & 63, F.lds + F.wave * PW_BYTES); }
        }
        SEAM(2 + 2 * s);
#ifdef REP_EXP
        if (IN(3 + 2 * s)) for (int it_ = 0, nrep_ = ((args.pad >= 103 && args.pad <= 108) ? 2 : 1); it_ < nrep_; ++it_) {
            const bool skip_scan = (args.pad == 105 && it_ == 0), skip_gemm = ((args.pad == 104 || (args.pad >= 106 && args.pad <= 108)) && it_ == 0); const int dfl = (it_ == 0 && args.pad >= 106 && args.pad <= 108) ? args.pad - 105 : 0;
#undef DRY
#define DRY(k) (it_ == 0 && nrep_ == 2)
#else
        if (IN(3 + 2 * s)) { const bool skip_scan = false, skip_gemm = false; const int dfl = 0;
#endif
            REFRESH();
            if (F.bid < 32) { if (!skip_scan) { const int br = F.bid >> 4, b = (F.bid >> 3) & 1, h = F.bid & 7;
                if (br == 0) scan_mfma<0>(args, F, s, b, h, DRY(103), dfl); else scan_mfma<1>(args, F, s, b, h, DRY(103), dfl); } }
            else if (skip_gemm) {}
            else if (s + 1 < NSEG) {
                pg8::Gemm g{(const bf16*)(F.ws + WS_XN) + (size_t)((s + 1) & 1) * MSEG * D, (const bf16*)(F.ws + WS_WIN), MSEG, NPROJ, D}; pg8::StaticOrder S; S.init(MSEG, NPROJ, F.G - 32, F.bid - 32);
                pg8::EpiP1 E{(bf16*)(F.ws + WS_P), (bf16*)F.out, (bf16*)(F.ws + WS_OA), (bf16*)(F.ws + WS_OB), (float*)(F.ws + WS_BA), s + 1};
                pg8::gemm_phase<pg8::EpiP1, pg8::StaticOrder, PG8_ALIGN, PG8_SP2>(F.lds, g, S, E);
                if (s + 2 < NSEG) norm_rows(args, F, s + 2, (bf16*)(F.ws + WS_XN) + (size_t)(s & 1) * MSEG * D, F.bid - 32, F.G - 32);
            } else { p0_weights(args, F, 2, F.bid - 32, F.G - 32); convert_experts(args, F, F.bid - 32, F.G - 32); }
        }
        SEAM(3 + 2 * s);
    }
    if (IN(10)) REPLOOP(110) {
        REFRESH();
        static_assert(WS_OB == WS_OA + (size_t)M * D * 2 && WS_WB == WS_WA + (size_t)D * D * 2, "F1: [OA | OB] and [Wa_t | Wb_t] are contiguous");
        pg8::F1Order S; S.S.init(M, D, F.G, F.bid);
        pg8::Gemm g{(const bf16*)(F.ws + WS_OA), (const bf16*)(F.ws + WS_WA), 2 * M, 2 * D, D};
        pg8::EpiF1 E{pg8::EpiGate<0>{(const bf16*)F.out, 2048, nullptr, (float*)(F.ws + WS_YA), nullptr, D}, pg8::EpiGate<1>{(const bf16*)F.out + 1024, 2048, (const float*)(F.ws + WS_YA), nullptr, (bf16*)(F.ws + WS_MIX), D}};
        pg8::gemm_phase<pg8::EpiF1, pg8::F1Order, PG8_ALIGN, PG8_SP2>(F.lds, g, S, E);
    }
    SEAM(10);
    if (IN(11)) REPLOOP(111) {
        REFRESH();
        pg8::Gemm g{(const bf16*)(F.ws + WS_MIX), (const bf16*)(F.ws + WS_WO), M, D, D}; pg8::StaticOrder S; S.init(M, D, F.G, F.bid);
        pg8::EpiResNorm E{args.in[0], F.out, (bf16*)(F.ws + WS_H2), args.in[12], (float*)(F.ws + WS_SSP), D};
        pg8::gemm_phase<pg8::EpiResNorm, pg8::StaticOrder, false, PG8_SP2>(F.lds, g, S, E);
    }
    if (IN(11) && IN(13)) xcd_barrier(bar);
    if (IN(13)) REPLOOP(113) {
        REFRESH();
        pg8::Gemm g{(const bf16*)(F.ws + WS_H2), (const bf16*)(F.ws + WS_WPQ), M, 2048, D}; pg8::StaticOrder S; S.init(M, 2048, F.G, F.bid);
        pg8::EpiBf16RowScale E{(bf16*)(F.ws + WS_Q2), 2048, (const float*)(F.ws + WS_SSP), 1.f / D, EPS};
        pg8::gemm_phase<pg8::EpiBf16RowScale, pg8::StaticOrder, PG8_ALIGN, PG8_SP2>(F.lds, g, S, E);
    }
    SEAM(13);
    if (IN(14)) REPLOOP(114) { REFRESH(); f5_topk(args, F); }
    SEAM(14);
#ifdef REP_EXP
    if (IN(15)) for (int it_ = 0, nrep_ = ((args.pad >= 115 && args.pad <= 120) ? 2 : 1); it_ < nrep_; ++it_) { REFRESH(); f6_peer(args, F, it_ == 0 && nrep_ == 2, it_ == 0 && (args.pad == 116 || args.pad == 120), (it_ == 0 && (args.pad == 117 || args.pad == 120)) ? 0xffu : ((it_ == 0 && args.pad == 118) ? 1u : ((it_ == 0 && args.pad == 119) ? 3u : 0x3fffu))); }
#else
    if (IN(15)) { REFRESH(); f6_peer(args, F, false); }
#endif
#undef IN
#undef REFRESH
#undef SEAM
}

extern "C" void kernel_launch(void* const* d_in, const int* in_sizes, int n_in, void* d_out, int out_size, void* d_ws, size_t ws_size, hipStream_t stream) {
    static int grid = 0;
    if (grid == 0) {
        if (n_in != 18 || out_size != M * D || ws_size < WS_NEED) { fprintf(stderr, "kernel_launch: unexpected shapes (n_in %d out %d ws %zu)\n", n_in, out_size, ws_size); grid = -1; return; }
        int dev = 0, cus = 0, per_cu = 0;
        if (hipGetDevice(&dev) != hipSuccess || hipDeviceGetAttribute(&cus, hipDeviceAttributeMultiprocessorCount, dev) != hipSuccess) { grid = -1; return; }
        if (hipFuncSetAttribute((const void*)mk_fwd, hipFuncAttributeMaxDynamicSharedMemorySize, LDS_BYTES) != hipSuccess) { fprintf(stderr, "kernel_launch: hipFuncSetAttribute failed\n"); grid = -1; return; }
        if (hipOccupancyMaxActiveBlocksPerMultiprocessor(&per_cu, (const void*)mk_fwd, NTHREADS, LDS_BYTES) != hipSuccess || per_cu < 1) fprintf(stderr, "kernel_launch: occupancy query says %d\n", per_cu);
        (void)hipGetLastError();
        grid = cus;
    }
    if (grid < 0) return;
    (void)hipMemsetAsync((char*)d_ws + WS_CTL, 0, CTL_ZERO_BYTES, stream);
    Args a{};
    for (int i = 0; i < 18; ++i) a.in[i] = (const float*)d_in[i];
    a.out = (float*)d_out; a.ws = (unsigned char*)d_ws;
#ifdef REP_EXP
    a.pad = REP_EXP;
#endif
#if MK_ONE_LAUNCH
    a.ph_lo = 0; a.ph_hi = NPHASE; a.use_bar = 1;
    hipLaunchKernelGGL(mk_fwd, dim3(grid), dim3(NTHREADS), LDS_BYTES, stream, a);
#else
    for (int ph = 0; ph < NPHASE; ++ph) { a.ph_lo = ph; a.ph_hi = ph + 1; a.use_bar = 0; hipLaunchKernelGGL(mk_fwd, dim3(grid), dim3(NTHREADS), LDS_BYTES, stream, a); }
#endif
}
```
